# Optimizing an MI355X kernel written in HIP

```python
import math
import jax, jax.numpy as jnp
from jax import lax
import numpy as np

D_MODEL = 1024
BATCH = 32
SEQ = 2048
DEPTH = 4

GRID_W = 64
CTX_LEN = 256
N_EVEN = (DEPTH + 1) // 2
N_ODD = DEPTH // 2
EPS = 1e-6
ROPE_BASE = 10000.0

RET_HEADS = 4
RET_DK = 128
RET_DV = 128
RET_QK_W = RET_HEADS * RET_DK
RET_W = RET_HEADS * RET_DV
RET_CHUNK = 128

POOL_GROUPS = 4
POOL_GC = 128
POOL_W = POOL_GROUPS * POOL_GC
POOL_WINDOWS = (2, 4, 8, 16)

EVEN_IN = 2 * RET_QK_W + 2 * RET_W + 2 * POOL_W
EVEN_OUT = RET_W + POOL_W

DIFF_HEADS = 8
DIFF_DH = 64
DIFF_DV = 2 * DIFF_DH
DIFF_QK_W = DIFF_HEADS * 2 * DIFF_DH
DIFF_W = DIFF_HEADS * DIFF_DV
ODD_IN = 2 * DIFF_QK_W + 2 * DIFF_W
Q_BLOCK = 128

kernel_name = "hybrid_retention_pool_diffattn_prefix_dit"


def rmsnorm(x, g):
    xf = x.astype(jnp.float32)
    y = xf * lax.rsqrt(jnp.mean(xf * xf, axis=-1, keepdims=True) + EPS)
    return (y * g.astype(jnp.float32)).astype(x.dtype)


def head_layernorm(x):
    xf = x.astype(jnp.float32)
    mu = jnp.mean(xf, axis=-1, keepdims=True)
    var = jnp.mean(jnp.square(xf - mu), axis=-1, keepdims=True)
    return ((xf - mu) * lax.rsqrt(var + EPS)).astype(x.dtype)


def _rot_half_axis(xa, pos):
    da = xa.shape[-1]
    freqs = ROPE_BASE ** (-jnp.arange(da // 2, dtype=jnp.float32) * 2.0 / da)
    ang = pos[:, None] * freqs[None, :]
    cos = jnp.cos(ang).astype(xa.dtype)
    sin = jnp.sin(ang).astype(xa.dtype)
    x1, x2 = xa[..., : da // 2], xa[..., da // 2:]
    return jnp.concatenate([x1 * cos - x2 * sin, x1 * sin + x2 * cos], axis=-1)


def axial_rope(x, rows, cols):
    half = x.shape[-1] // 2
    return jnp.concatenate([_rot_half_axis(x[..., :half], rows), _rot_half_axis(x[..., half:], cols)], axis=-1)


def to_heads(t, n_heads):
    b, s, _ = t.shape
    return t.reshape(b, s, n_heads, -1).transpose(0, 2, 1, 3)


def from_heads(t):
    b, h, s, d = t.shape
    return t.transpose(0, 2, 1, 3).reshape(b, s, h * d)


def retention_scan(q, k, v, log_g, s0, strict, reverse):
    if reverse:
        q, k, v = jnp.flip(q, axis=2), jnp.flip(k, axis=2), jnp.flip(v, axis=2)
    b, h, t, dk = q.shape
    dv = v.shape[-1]
    n = t // RET_CHUNK
    idx = jnp.arange(RET_CHUNK, dtype=jnp.float32)
    rel = idx[:, None] - idx[None, :]
    mask = (rel > 0) if strict else (rel >= 0)
    lg = log_g.astype(jnp.float32)
    intra = jnp.where(mask[None], jnp.exp(lg[:, None, None] * jnp.where(mask, rel, 0.0)[None]), 0.0).astype(q.dtype)
    q_dec = jnp.exp(lg[:, None] * (idx + 1.0))[..., None].astype(q.dtype)
    k_dec = jnp.exp(lg[:, None] * (RET_CHUNK - 1.0 - idx))[..., None].astype(q.dtype)
    c_dec = jnp.exp(lg * RET_CHUNK)[:, None, None].astype(q.dtype)

    def chunks(a):
        return jnp.moveaxis(a.reshape(b, h, n, RET_CHUNK, a.shape[-1]), 2, 0)

    def step(s, inp):
        qc, kc, vc = inp
        sc = jnp.einsum('bhid,bhjd->bhij', qc, kc) * intra
        o = jnp.einsum('bhij,bhjv->bhiv', sc, vc) + jnp.einsum('bhid,bhdv->bhiv', qc * q_dec, s)
        s = s * c_dec + jnp.einsum('bhjd,bhjv->bhdv', kc * k_dec, vc)
        return s, o

    s, o = lax.scan(step, s0, (chunks(q), chunks(k), chunks(v)))
    o = jnp.moveaxis(o, 0, 2).reshape(b, h, t, dv)
    if reverse:
        o = jnp.flip(o, axis=2)
    return o, s


def pool_mix(p, pool_w, pool_scale):
    b, t, _ = p.shape
    csum = jnp.concatenate([jnp.zeros((b, 1, POOL_W), jnp.float32), jnp.cumsum(p.astype(jnp.float32), axis=1)], axis=1)
    pos = jnp.arange(t)
    outs = []
    for g, win in enumerate(POOL_WINDOWS):
        lo = jnp.maximum(pos - win // 2, 0)
        hi = jnp.minimum(pos + win - win // 2 - 1, t - 1)
        cg = csum[..., g * POOL_GC:(g + 1) * POOL_GC]
        mean = (cg[:, hi + 1] - cg[:, lo]) / (hi - lo + 1).astype(jnp.float32)[None, :, None]
        outs.append(mean.astype(p.dtype) - p[..., g * POOL_GC:(g + 1) * POOL_GC])
    d = jnp.stack(outs, axis=2)
    y = jnp.einsum('btgc,gcd->btgd', d, pool_w).reshape(b, t, POOL_W)
    return y * pool_scale


def even_mixer(h, hc, w_in, w_out, decay_logit, pool_w, pool_scale, rows, cols, ctx_out):
    cut = [RET_QK_W, 2 * RET_QK_W, 2 * RET_QK_W + RET_W, 2 * RET_QK_W + 2 * RET_W, 2 * RET_QK_W + 2 * RET_W + POOL_W]
    q, k, v, g_r, p, g_p = jnp.split(h @ w_in, cut, axis=-1)
    qc, kc, vc, g_rc, pc, g_pc = jnp.split(hc @ w_in, cut, axis=-1)
    kscale = RET_DK ** -0.5
    q = axial_rope(to_heads(q, RET_HEADS), rows, cols)
    k = axial_rope(to_heads(k, RET_HEADS), rows, cols) * kscale
    v = to_heads(v, RET_HEADS)
    qc, kc, vc = to_heads(qc, RET_HEADS), to_heads(kc, RET_HEADS) * kscale, to_heads(vc, RET_HEADS)
    log_g = -jnp.exp(decay_logit.astype(jnp.float32))
    b = h.shape[0]
    s_zero = jnp.zeros((b, RET_HEADS, RET_DK, RET_DV), q.dtype)
    oc_f, sc_f = retention_scan(qc, kc, vc, log_g[0], s_zero, False, False)
    oc_b, sc_b = retention_scan(qc, kc, vc, log_g[1], s_zero, True, True)
    o_f, _ = retention_scan(q, k, v, log_g[0], sc_f, False, False)
    o_b, _ = retention_scan(q, k, v, log_g[1], sc_b, True, True)
    ret = from_heads(head_layernorm(o_f + o_b)) * jax.nn.silu(g_r)
    pool = pool_mix(p, pool_w, pool_scale) * jax.nn.silu(g_p)
    y = jnp.concatenate([ret, pool], axis=-1) @ w_out
    if not ctx_out:
        return y, None
    ret_c = from_heads(head_layernorm(oc_f + oc_b)) * jax.nn.silu(g_rc)
    pool_c = pool_mix(pc, pool_w, pool_scale) * jax.nn.silu(g_pc)
    yc = jnp.concatenate([ret_c, pool_c], axis=-1) @ w_out
    return y, yc


def diff_attend(q, k, v, lam):
    s = jnp.einsum('bhmqd,bhmkd->bhmqk', q, k).astype(jnp.float32) * (DIFF_DH ** -0.5)
    p = jax.nn.softmax(s, axis=-1)
    a = (p[:, :, 0] - lam * p[:, :, 1]).astype(v.dtype)
    return jnp.einsum('bhqk,bhkv->bhqv', a, v)


def diff_attend_blocks(q, k, v, lam):
    b, h, m, t, dh = q.shape
    nb = t // Q_BLOCK
    qb = jnp.moveaxis(q.reshape(b, h, m, nb, Q_BLOCK, dh), 3, 0)
    o = lax.map(lambda qi: diff_attend(qi, k, v, lam), qb)
    return jnp.moveaxis(o, 0, 2).reshape(b, h, t, v.shape[-1])


def odd_mixer(h, hc, w_in, w_out, lam_p, subln, layer_idx, rows, cols, ctx_out):
    cut = [DIFF_QK_W, 2 * DIFF_QK_W, 2 * DIFF_QK_W + DIFF_W]
    q, k, v, g = jnp.split(h @ w_in, cut, axis=-1)
    qc, kc, vc, gc = jnp.split(hc @ w_in, cut, axis=-1)

    def split_qk(t):
        b, s, _ = t.shape
        return t.reshape(b, s, DIFF_HEADS, 2, DIFF_DH).transpose(0, 2, 3, 1, 4)

    q = axial_rope(split_qk(q), rows, cols)
    k = axial_rope(split_qk(k), rows, cols)
    v = to_heads(v, DIFF_HEADS)
    qc, kc, vc = split_qk(qc), split_qk(kc), to_heads(vc, DIFF_HEADS)
    lam_init = 0.8 - 0.6 * math.exp(-0.3 * layer_idx)
    lp = lam_p.astype(jnp.float32)
    lam = jnp.exp(jnp.sum(lp[0] * lp[1])) - jnp.exp(jnp.sum(lp[2] * lp[3])) + lam_init
    k_all = jnp.concatenate([kc, k], axis=3)
    v_all = jnp.concatenate([vc, v], axis=2)
    o = diff_attend_blocks(q, k_all, v_all, lam)
    o = from_heads(rmsnorm(o, subln) * (1.0 - lam_init)) * jax.nn.silu(g)
    y = o @ w_out
    if not ctx_out:
        return y, None
    oc = diff_attend(qc, kc, vc, lam)
    oc = from_heads(rmsnorm(oc, subln) * (1.0 - lam_init)) * jax.nn.silu(gc)
    return y, oc @ w_out


def setup_inputs(seed: int = 0) -> dict:
    key = jax.random.key(seed)
    ks = jax.random.split(key, 18)
    f32 = jnp.float32
    d = D_MODEL
    base_decay = jnp.log(-jnp.log1p(-(2.0 ** (-5.0 - jnp.arange(RET_HEADS, dtype=f32)))))
    return {
        "x": jax.random.normal(ks[0], (BATCH, SEQ, d), f32),
        "c": jax.random.normal(ks[1], (BATCH, d), f32),
        "ctx": jax.random.normal(ks[2], (BATCH, CTX_LEN, d), f32),
        "c_ctx": jax.random.normal(ks[3], (d,), f32),
        "ada_w": jax.random.normal(ks[4], (DEPTH, d, 3 * d), f32) * (0.5 * d ** -0.5),
        "ada_b": jax.random.normal(ks[5], (DEPTH, 3 * d), f32) * 0.01,
        "norm_pre": 1.0 + 0.05 * jax.random.normal(ks[6], (DEPTH, d), f32),
        "norm_post": 1.0 + 0.05 * jax.random.normal(ks[7], (DEPTH, d), f32),
        "ev_w_in": jax.random.normal(ks[8], (N_EVEN, d, EVEN_IN), f32) * d ** -0.5,
        "ev_w_out": jax.random.normal(ks[9], (N_EVEN, EVEN_OUT, d), f32) * EVEN_OUT ** -0.5,
        "ret_decay_logit": base_decay[None, None, :] + 0.05 * jax.random.normal(ks[10], (N_EVEN, 2, RET_HEADS), f32),
        "pool_w": jax.random.normal(ks[11], (N_EVEN, POOL_GROUPS, POOL_GC, POOL_GC), f32) * POOL_GC ** -0.5,
        "pool_scale": 1.0 + 0.1 * jax.random.normal(ks[12], (N_EVEN, POOL_W), f32),
        "od_w_in": jax.random.normal(ks[13], (N_ODD, d, ODD_IN), f32) * d ** -0.5,
        "od_w_out": jax.random.normal(ks[14], (N_ODD, DIFF_W, d), f32) * DIFF_W ** -0.5,
        "diff_lambda": 0.1 * jax.random.normal(ks[15], (N_ODD, 4, DIFF_DH), f32),
        "diff_subln": 1.0 + 0.05 * jax.random.normal(ks[16], (N_ODD, DIFF_DV), f32),
    }


def reference(x, c, ctx, c_ctx, ada_w, ada_b, norm_pre, norm_post, ev_w_in, ev_w_out, ret_decay_logit,
              pool_w, pool_scale, od_w_in, od_w_out, diff_lambda, diff_subln):
    t = x.shape[1]
    ROWS = t // GRID_W
    rows = jnp.repeat(jnp.arange(ROWS), GRID_W).astype(jnp.float32)
    cols = jnp.tile(jnp.arange(GRID_W), ROWS).astype(jnp.float32)
    xc = ctx
    for l in range(DEPTH):
        ctx_out = l < DEPTH - 1
        mod = jax.nn.silu(c) @ ada_w[l] + ada_b[l]
        shift, scale, gate = jnp.split(mod[:, None, :], 3, axis=-1)
        mod_c = jax.nn.silu(c_ctx) @ ada_w[l] + ada_b[l]
        shift_c, scale_c, gate_c = jnp.split(mod_c, 3, axis=-1)
        h = rmsnorm(x, norm_pre[l]) * (1.0 + scale) + shift
        hc = rmsnorm(xc, norm_pre[l]) * (1.0 + scale_c) + shift_c
        i = l // 2
        if l % 2 == 0:
            y, yc = even_mixer(h, hc, ev_w_in[i], ev_w_out[i], ret_decay_logit[i], pool_w[i], pool_scale[i],
                               rows, cols, ctx_out)
        else:
            y, yc = odd_mixer(h, hc, od_w_in[i], od_w_out[i], diff_lambda[i], diff_subln[i], l,
                              rows, cols, ctx_out)
        x = x + gate * rmsnorm(y, norm_post[l])
        if ctx_out:
            xc = xc + gate_c * rmsnorm(yc, norm_post[l])
    return x
```

```cpp
#include <hip/hip_runtime.h>
#include <hip/hip_cooperative_groups.h>
#include <cstdio>
#include <cstdint>
namespace cg = cooperative_groups;
namespace pg8 {
#define PG8_LAS __attribute__((address_space(3)))
typedef unsigned short bf16_t;
typedef short bf16x8 __attribute__((ext_vector_type(8)));
typedef float f32x4 __attribute__((ext_vector_type(4)));
typedef unsigned u32x4 __attribute__((ext_vector_type(4)));
constexpr int BM = 256, BK = 64, HALF = 128, HTB = HALF * BK * 2  , STAGE_BYTES = 8 * HTB, NXCD = 8, WGM = 8;

__host__ __device__ __forceinline__ int lds_byte(int r, int c) { const int st = (r >> 4) * 2 + (c >> 5), rr = r & 15, cc = c & 31, ob = rr * 64 + cc * 2; return st * 1024 + (ob ^ (((ob >> 9) & 1) << 5)); }
__host__ __device__ __forceinline__ void stage_rc(int b, int& R, int& C) { const int st = b / 1024, sb = b % 1024, swz = sb ^ (((sb >> 9) & 1) << 5); R = (st >> 1) * 16 + swz / 64; C = (st & 1) * 32 + (swz % 64) / 2; }
__host__ __device__ __forceinline__ int perm32(int rho) { const int n = rho >> 4, i = rho & 15; return 8 * (i >> 2) + 4 * n + (i & 3); }

struct Unit { int pm, pn; };
struct Gemm { const bf16_t* A; const bf16_t* Bt; int M, N, K; };

struct StaticOrder {
    int nM, nN, nwg, G, c;
    __host__ __device__ void init(int M, int N, int G_, int c_) { nM = M / BM; nN = N / BM; nwg = nM * nN; G = G_; c = c_; }
    __host__ __device__ bool next(int i, Unit& u) const {
        const long L = (long)i * G + c; if (L >= nwg) return false;
        int wgid = (int)L; { const int q = nwg / NXCD, r = nwg % NXCD, xcd = wgid % NXCD, off = wgid / NXCD; wgid = (xcd < r ? xcd * (q + 1) : r * (q + 1) + (xcd - r) * q) + off; }
        const int nig = WGM * nN, gid = wgid / nig, fm = gid * WGM, gsz = (nM - fm) < WGM ? (nM - fm) : WGM;
        u.pm = fm + ((wgid % nig) % gsz); u.pn = (wgid % nig) / gsz; return true;
    }
    __device__ __forceinline__ void a_ready(const Unit&) const {}
    __device__ __forceinline__ void done(const Unit&) const {}
};
__device__ __forceinline__ unsigned cvt_pk_bf16(float lo, float hi) { unsigned r; asm volatile("v_cvt_pk_bf16_f32 %0, %1, %2" : "=v"(r) : "v"(lo), "v"(hi)); return r; }
typedef float f32x2 __attribute__((ext_vector_type(2)));
template <class Epi, class Sched, bool STAMP = false>
__device__ __forceinline__ void gemm_phase(PG8_LAS unsigned char* lds, const Gemm g, const Sched& S, const Epi& E, unsigned long long* stamps) {
    const int tid = threadIdx.x, wid = __builtin_amdgcn_readfirstlane(tid >> 6), lane = tid & 63, wr = wid >> 2, wc = wid & 3, fr = lane & 15, fq = lane >> 4;
    const int K = g.K, nt = K / BK;
    int ts_lo = 0, ts_hi = 0, nts = 0; const unsigned long long rt_entry = STAMP ? (unsigned long long)wall_clock64() : 0ull;
#define PG8_STAMP() do { if (STAMP && wid == 0 && nts < 64) { const unsigned long long _c = (unsigned long long)clock64(); \
        ts_lo = (lane == nts) ? (int)(unsigned)_c : ts_lo; ts_hi = (lane == nts) ? (int)(unsigned)(_c >> 32) : ts_hi; ++nts; } } while (0)
    PG8_STAMP();
    unsigned voffA[2], voffB[2];
#pragma unroll
    for (int i = 0; i < 2; ++i) { int R, C; stage_rc(tid * 16 + i * 8192, R, C); const int Rb = Epi::PERM ? ((R & ~31) + perm32(R & 31)) : R;
        voffA[i] = (unsigned)(R * K + C) * 2u; voffB[i] = (unsigned)(Rb * K + C) * 2u; }
    const size_t kstep = (size_t)(BK * 2);
    const size_t hstep = (size_t)HALF * K * 2;
    const size_t tstep = 2 * hstep;
    const unsigned ldsw = (unsigned)wid * 1024u;
    const int aoff = lds_byte(wr * 64 + fr, fq * 8), boff = lds_byte(wc * 32 + fr, fq * 8);
#define PG8_SA(b, h) (((b) * 2 + (h)) * HTB)
#define PG8_SB(b, h) ((4 + (b) * 2 + (h)) * HTB)
#define PG8_STAGE(bufoff, gbase, voff) do { _Pragma("unroll") for (int _i = 0; _i < 2; ++_i) \
        __builtin_amdgcn_global_load_lds((const unsigned*)((const char*)(gbase) + (voff)[_i]), (PG8_LAS unsigned*)(lds + (bufoff) + ldsw + _i * 8192), 16, 0, 0); } while (0)
#define PG8_LDA(dst, b, h) do { _Pragma("unroll") for (int m = 0; m < 4; ++m) _Pragma("unroll") for (int k = 0; k < 2; ++k) dst[m][k] = *(const PG8_LAS bf16x8*)(lds + PG8_SA(b, h) + aoff + m * 2048 + k * 1024); } while (0)
#define PG8_LDB(dst, b, h) do { _Pragma("unroll") for (int n = 0; n < 2; ++n) _Pragma("unroll") for (int k = 0; k < 2; ++k) dst[n][k] = *(const PG8_LAS bf16x8*)(lds + PG8_SB(b, h) + boff + n * 2048 + k * 1024); } while (0)
#define PG8_MMA(ai, bj, At, Bt) do { __builtin_amdgcn_s_setprio(1); _Pragma("unroll") for (int m = 0; m < 4; ++m) _Pragma("unroll") for (int n = 0; n < 2; ++n) _Pragma("unroll") for (int k = 0; k < 2; ++k) \
        acc[ai][bj][m][n] = __builtin_amdgcn_mfma_f32_16x16x32_bf16(Bt[n][k], At[m][k], acc[ai][bj][m][n], 0, 0, 0); __builtin_amdgcn_s_setprio(0); } while (0)
#define PG8_WAIT_V(n) asm volatile("s_waitcnt vmcnt(" #n ")" ::: "memory")
#define PG8_WAIT_L(n) asm volatile("s_waitcnt lgkmcnt(" #n ")" ::: "memory")
#define PG8_BAR __builtin_amdgcn_s_barrier()
#define PG8_SCHED __builtin_amdgcn_sched_barrier(0)
    Unit cur, nxt; int ui = 0;
    if (!S.next(0, cur)) return;
    f32x4 acc[2][2][4][2];
#pragma unroll
    for (int a = 0; a < 2; ++a)
#pragma unroll
        for (int b = 0; b < 2; ++b)
#pragma unroll
            for (int m = 0; m < 4; ++m)
#pragma unroll
                for (int n = 0; n < 2; ++n) acc[a][b][m][n] = (f32x4){0.f, 0.f, 0.f, 0.f};
    bf16x8 At[4][2], B0[2][2], B1[2][2];
    const char* cA = (const char*)g.A + (size_t)cur.pm * tstep; const char* cB = (const char*)g.Bt + (size_t)cur.pn * tstep;
    S.a_ready(cur);
    PG8_STAGE(PG8_SB(0, 0), cB, voffB); PG8_STAGE(PG8_SA(0, 0), cA, voffA); PG8_STAGE(PG8_SB(0, 1), cB + hstep, voffB); PG8_STAGE(PG8_SA(0, 1), cA + hstep, voffA);
    if (wr == 1) PG8_BAR;
    PG8_WAIT_V(4); PG8_BAR;
    PG8_STAGE(PG8_SB(1, 0), cB + kstep, voffB); PG8_STAGE(PG8_SA(1, 0), cA + kstep, voffA); PG8_STAGE(PG8_SB(1, 1), cB + hstep + kstep, voffB);
    PG8_WAIT_V(6); PG8_BAR;
    PG8_STAMP();
    for (;;) {
        const bool has_next = S.next(ui + 1, nxt);
        const char* nA = has_next ? (const char*)g.A + (size_t)nxt.pm * tstep : cA; const char* nB = has_next ? (const char*)g.Bt + (size_t)nxt.pn * tstep : cB;
        for (int t = 0; t < nt; t += 2) {
            const bool last = (t == nt - 2);
            const char* a1 = cA + (size_t)(t + 1) * kstep;
            const char* a2 = last ? nA : cA + (size_t)(t + 2) * kstep; const char* b2 = last ? nB : cB + (size_t)(t + 2) * kstep;
            const char* a3 = a2 + kstep; const char* b3 = b2 + kstep;
            if (last && has_next) S.a_ready(nxt);
            PG8_LDB(B0, 0, 0); PG8_SCHED; PG8_LDA(At, 0, 0); PG8_STAGE(PG8_SA(1, 1), a1 + hstep, voffA);
            PG8_WAIT_L(8); PG8_BAR; PG8_WAIT_L(0); PG8_MMA(0, 0, At, B0); PG8_BAR; PG8_SCHED;
            PG8_LDB(B1, 0, 1); PG8_STAGE(PG8_SB(0, 0), b2, voffB);
            PG8_BAR; PG8_WAIT_L(0); PG8_MMA(0, 1, At, B1); PG8_BAR;
            PG8_LDA(At, 0, 1); PG8_STAGE(PG8_SA(0, 0), a2, voffA);
            PG8_BAR; PG8_WAIT_L(0); PG8_MMA(1, 0, At, B0); PG8_BAR; PG8_SCHED;
            PG8_STAGE(PG8_SB(0, 1), b2 + hstep, voffB);
            PG8_WAIT_V(6); PG8_BAR; PG8_MMA(1, 1, At, B1); PG8_BAR;
            PG8_LDB(B0, 1, 0); PG8_SCHED; PG8_LDA(At, 1, 0); PG8_STAGE(PG8_SA(0, 1), a2 + hstep, voffA);
            PG8_WAIT_L(8); PG8_BAR; PG8_WAIT_L(0); PG8_MMA(0, 0, At, B0); PG8_BAR; PG8_SCHED;
            PG8_LDB(B1, 1, 1); PG8_STAGE(PG8_SB(1, 0), b3, voffB);
            PG8_BAR; PG8_WAIT_L(0); PG8_MMA(0, 1, At, B1); PG8_BAR;
            PG8_LDA(At, 1, 1); PG8_STAGE(PG8_SA(1, 0), a3, voffA);
            PG8_BAR; PG8_WAIT_L(0); PG8_MMA(1, 0, At, B0); PG8_BAR; PG8_SCHED;
            PG8_STAGE(PG8_SB(1, 1), b3 + hstep, voffB);
            PG8_WAIT_V(6); PG8_BAR; PG8_MMA(1, 1, At, B1); PG8_BAR;
        }
        PG8_STAMP();
        if constexpr (!Epi::AFTER_DRAIN) { E(acc, cur, wr, wc, fr, fq); S.done(cur); }
        PG8_STAMP();
        if (!has_next) break;
#pragma unroll
        for (int a = 0; a < 2; ++a)
#pragma unroll
            for (int b = 0; b < 2; ++b)
#pragma unroll
                for (int m = 0; m < 4; ++m)
#pragma unroll
                    for (int n = 0; n < 2; ++n) acc[a][b][m][n] = (f32x4){0.f, 0.f, 0.f, 0.f};
        cur = nxt; cA = nA; cB = nB; ++ui;
    }
    PG8_WAIT_V(0);
    if (wr == 0) PG8_BAR;
    PG8_BAR;
    if constexpr (Epi::AFTER_DRAIN) { E.fused(acc, cur, wr, wc, fr, fq, lds, wid, lane); S.done(cur); }
    PG8_STAMP();
    if (STAMP && wid == 0) { stamps[lane] = lane < nts ? (((unsigned long long)(unsigned)ts_hi << 32) | (unsigned)ts_lo) : 0ull;
        if (lane == 62) stamps[62] = rt_entry; if (lane == 63) stamps[63] = (unsigned long long)wall_clock64(); }
#undef PG8_STAMP
#undef PG8_SA
#undef PG8_SB
#undef PG8_STAGE
#undef PG8_LDA
#undef PG8_LDB
#undef PG8_MMA
#undef PG8_WAIT_V
#undef PG8_WAIT_L
#undef PG8_BAR
#undef PG8_SCHED
}
}

#define LAS __attribute__((address_space(3)))
using pg8::bf16_t; using pg8::bf16x8; using pg8::f32x4; using pg8::u32x4; using pg8::cvt_pk_bf16;
typedef unsigned u32x2 __attribute__((ext_vector_type(2)));
typedef float f32x2v __attribute__((ext_vector_type(2)));

constexpr int D = 1024, NB = 32, SEQ = 2048, CTXL = 256, SROW = 2304, NTOK = NB * SROW;
constexpr float EPS = 1e-6f;
constexpr int NTHREADS = 512;
constexpr int LDS_BYTES = 147456;
constexpr size_t MiB = 1u << 20;
constexpr size_t WS_MOD = 1 * MiB;
constexpr size_t WS_TABR = 3 * MiB;
constexpr size_t WS_TABRT = WS_TABR + 65536;
constexpr size_t WS_TABD = WS_TABRT + 65536;
constexpr size_t WS_WTE = 4 * MiB;
constexpr size_t WS_WTO = 16 * MiB;
constexpr size_t WS_WOT = 32 * MiB;
constexpr size_t WS_PWT = 40 * MiB;
constexpr size_t WS_XC = 48 * MiB;
constexpr size_t WS_H = 80 * MiB;
constexpr size_t WS_P = 224 * MiB;
constexpr size_t WS_T = 656 * MiB;
constexpr size_t WS_OF = 800 * MiB;
constexpr size_t WS_END = 944 * MiB;

struct Args { const float* in[17]; float* out; unsigned char* ws; int ph_lo, ph_hi; };

__device__ __forceinline__ float bf2f(unsigned short u) { return __uint_as_float(((unsigned)u) << 16); }
__device__ __forceinline__ float bflo(unsigned w) { return __uint_as_float(w << 16); }
__device__ __forceinline__ float bfhi(unsigned w) { return __uint_as_float(w & 0xffff0000u); }
__device__ __forceinline__ float silu_f(float x) { return x * __builtin_amdgcn_rcpf(1.0f + __expf(-x)); }
__device__ __forceinline__ f32x4 mfma16(bf16x8 a, bf16x8 b, f32x4 c) { return __builtin_amdgcn_mfma_f32_16x16x32_bf16(a, b, c, 0, 0, 0); }
__device__ __forceinline__ float wave_sum(float v) {
#pragma unroll
    for (int o = 32; o >= 1; o >>= 1) v += __shfl_xor(v, o);
    return v;
}

template <int odd> struct EpiInNat {
    static constexpr bool PERM = true, AFTER_DRAIN = false;
    bf16_t* O; int ldc; const f32x4* tab;
    __device__ __forceinline__ void operator()(const f32x4 (&acc)[2][2][4][2], const pg8::Unit& u, int wr, int wc, int fr, int fq) const {
        const int pn = u.pn;
        const bool latent = (u.pm % 9) != 0;
        bool rope; float scl = 1.0f; int ax, i0, nf;
        if (odd) { rope = latent && pn < 8; ax = wc & 1; i0 = 4 * fq; nf = 16; }
        else { rope = latent && (pn < 2 || pn >= 8); ax = wc >> 1; i0 = 16 * (wc & 1) + 4 * fq; nf = 32; if (pn >= 8) scl = 0.08838834764831845f; }
        const int srow0 = (u.pm % 9) * 256 + wr * 64 + fr;
        const size_t row0 = (size_t)u.pm * 256 + wr * 64 + fr; const int col0 = pn * 256 + wc * 32 + 8 * fq;
#pragma unroll
        for (int ai = 0; ai < 2; ++ai)
#pragma unroll
            for (int m = 0; m < 4; ++m) {
                f32x4 cs0 = {1.f, 0.f, 1.f, 0.f}, cs1 = {1.f, 0.f, 1.f, 0.f};
                if (rope) { const int t = srow0 + ai * 128 + m * 16 - 256; const int pos = ax ? (t & 63) : (t >> 6);
                    const f32x4* tp = tab + ((pos * nf + i0) >> 1); cs0 = tp[0]; cs1 = tp[1]; }
                bf16_t* rowp = O + (row0 + ai * 128 + m * 16) * (size_t)ldc + col0;
#pragma unroll
                for (int bj = 0; bj < 2; ++bj) {
                    const f32x4 v0 = acc[ai][bj][m][0], v1 = acc[ai][bj][m][1];
                    const float a0 = (v0[0] * cs0[0] - v0[1] * cs0[1]) * scl, a1 = (v0[0] * cs0[1] + v0[1] * cs0[0]) * scl;
                    const float a2 = (v0[2] * cs0[2] - v0[3] * cs0[3]) * scl, a3 = (v0[2] * cs0[3] + v0[3] * cs0[2]) * scl;
                    const float b0 = (v1[0] * cs1[0] - v1[1] * cs1[1]) * scl, b1 = (v1[0] * cs1[1] + v1[1] * cs1[0]) * scl;
                    const float b2 = (v1[2] * cs1[2] - v1[3] * cs1[3]) * scl, b3 = (v1[2] * cs1[3] + v1[3] * cs1[2]) * scl;
                    u32x4 w; w.x = cvt_pk_bf16(a0, a1); w.y = cvt_pk_bf16(a2, a3); w.z = cvt_pk_bf16(b0, b1); w.w = cvt_pk_bf16(b2, b3);
                    *(u32x4*)(rowp + bj * 128) = w;
                }
            }
    }
};
template <int ropek> struct EpiSwap {
    static constexpr bool PERM = true, AFTER_DRAIN = false;
    bf16_t* O; const float* tabT;
    __device__ __forceinline__ void operator()(const f32x4 (&acc)[2][2][4][2], const pg8::Unit& u, int wr, int wc, int fr, int fq) const {
        const bool isk = ropek && u.pm < 2;
        const bool latent = (u.pn % 9) != 0;
        const size_t row0 = (size_t)u.pm * 256 + wr * 64 + fr; const size_t col0 = (size_t)u.pn * 256 + wc * 32 + 8 * fq;
        const float sgn = (fr & 1) ? 1.0f : -1.0f;
        const float scl = isk ? 0.08838834764831845f : 1.0f;
#pragma unroll
        for (int ai = 0; ai < 2; ++ai)
#pragma unroll
            for (int m = 0; m < 4; ++m) {
                bf16_t* rowp = O + (row0 + ai * 128 + m * 16) * (size_t)NTOK + col0;
                const int fi = 8 * m + (fr >> 1);
#pragma unroll
                for (int bj = 0; bj < 2; ++bj) {
                    f32x4 v0 = acc[ai][bj][m][0], v1 = acc[ai][bj][m][1];
                    if (isk && latent) {
                        const int t0 = (u.pn % 9) * 256 + bj * 128 + wc * 32 + 8 * fq - 256;
                        const float* tb = tabT + 2 * (fi * 64 + (wr == 0 ? (t0 >> 6) : (t0 & 63)));
                        const int st = (wr == 0) ? 0 : 2;
#pragma unroll
                        for (int e = 0; e < 4; ++e) { const float pp = __shfl_xor(v0[e], 1); const f32x2v cs = *(const f32x2v*)(tb + st * e); v0[e] = v0[e] * cs.x + sgn * pp * cs.y; }
#pragma unroll
                        for (int e = 0; e < 4; ++e) { const float pp = __shfl_xor(v1[e], 1); const f32x2v cs = *(const f32x2v*)(tb + st * (4 + e)); v1[e] = v1[e] * cs.x + sgn * pp * cs.y; }
                    }
                    u32x4 w; w.x = cvt_pk_bf16(v0[0] * scl, v0[1] * scl); w.y = cvt_pk_bf16(v0[2] * scl, v0[3] * scl); w.z = cvt_pk_bf16(v1[0] * scl, v1[1] * scl); w.w = cvt_pk_bf16(v1[2] * scl, v1[3] * scl);
                    *(u32x4*)(rowp + bj * 128) = w;
                }
            }
    }
};
struct EpiF32 {
    static constexpr bool PERM = false, AFTER_DRAIN = false;
    float* C; int ldc;
    __device__ __forceinline__ void operator()(const f32x4 (&acc)[2][2][4][2], const pg8::Unit& u, int wr, int wc, int fr, int fq) const {
        const size_t row0 = (size_t)u.pm * 256 + wr * 64 + fr; const int col0 = u.pn * 256 + wc * 32 + 4 * fq;
#pragma unroll
        for (int ai = 0; ai < 2; ++ai)
#pragma unroll
            for (int m = 0; m < 4; ++m) { float* rowp = C + (row0 + ai * 128 + m * 16) * (size_t)ldc + col0;
#pragma unroll
                for (int bj = 0; bj < 2; ++bj)
#pragma unroll
                    for (int n = 0; n < 2; ++n) *(f32x4*)(rowp + bj * 128 + n * 16) = acc[ai][bj][m][n]; }
    }
};

__device__ __forceinline__ int src_col(int mode, int n) {
    if (mode == 0) {
        const int sec = n >> 9, within = n & 511;
        const int base = (sec == 0) ? 0 : (sec == 1) ? 1536 : (sec == 2) ? 2048 : (sec == 3) ? 2560 : (sec == 4) ? 512 : 1024;
        if (sec == 0 || sec == 4) { const int head = within >> 7, np = within & 127, pp = np >> 1, which = np & 1, a = pp >> 5, i = pp & 31; return base + head * 128 + 64 * a + 32 * which + i; }
        return base + within;
    } else if (mode == 1) {
        const int sec = n >> 10, within = n & 1023;
        const int base = (sec == 0) ? 0 : (sec == 1) ? 1024 : (sec == 2) ? 3072 : 2048;
        if (sec < 2) { const int grp = within >> 6, np = within & 63, pp = np >> 1, which = np & 1, a = pp >> 4, i = pp & 15; return base + grp * 64 + 32 * a + 16 * which + i; }
        return base + within;
    }
    return n;
}
__device__ __forceinline__ void conv_w(bf16_t* dst, const float* src, int nrows, int K, int ld, int mode, int gtid, int gthreads) {
    const int items = nrows * (K >> 3);
    for (int it = gtid; it < items; it += gthreads) {
        const int n = it % nrows, k8 = it / nrows;
        const float* s = src + (size_t)(k8 * 8) * ld + src_col(mode, n);
        float v[8];
#pragma unroll
        for (int e = 0; e < 8; ++e) v[e] = s[(size_t)e * ld];
        u32x4 w; w.x = cvt_pk_bf16(v[0], v[1]); w.y = cvt_pk_bf16(v[2], v[3]); w.z = cvt_pk_bf16(v[4], v[5]); w.w = cvt_pk_bf16(v[6], v[7]);
        *(u32x4*)(dst + (size_t)n * K + k8 * 8) = w;
    }
}

__device__ __forceinline__ void prologue_phase(const Args& A, LAS unsigned char* lds) {
    const int tid = threadIdx.x, lane = tid & 63, wave = tid >> 6, G = gridDim.x, bx = blockIdx.x;
    unsigned char* ws = A.ws;
    float* MOD = (float*)(ws + WS_MOD);
    for (int u = bx; u < 192; u += G) {
        const int l = u / 48, n0 = (u % 48) * 64;
        LAS float* sl = (LAS float*)lds;
        for (int idx = tid; idx < 33 * 1024; idx += NTHREADS) { const int v = idx >> 10, k = idx & 1023; const float x = (v < 32) ? A.in[1][v * 1024 + k] : A.in[3][k]; sl[idx] = silu_f(x); }
        __syncthreads();
        float acc[33];
#pragma unroll
        for (int v = 0; v < 33; ++v) acc[v] = 0.f;
        const float* w = A.in[4] + ((size_t)l * 1024 + wave * 128) * 3072 + n0 + lane;
        for (int kk = 0; kk < 128; ++kk) { const float wv = w[(size_t)kk * 3072]; const int k = wave * 128 + kk;
#pragma unroll
            for (int v = 0; v < 33; ++v) acc[v] += sl[v * 1024 + k] * wv; }
        __syncthreads();
#pragma unroll
        for (int v = 0; v < 33; ++v) sl[(wave * 33 + v) * 64 + lane] = acc[v];
        __syncthreads();
        for (int idx = tid; idx < 33 * 64; idx += NTHREADS) { const int v = idx >> 6, ln = idx & 63; float s = 0.f;
#pragma unroll
            for (int w8 = 0; w8 < 8; ++w8) s += sl[(w8 * 33 + v) * 64 + ln];
            MOD[(size_t)(l * 33 + v) * 3072 + n0 + ln] = s + A.in[5][l * 3072 + n0 + ln]; }
        __syncthreads();
    }
    const int gtid = bx * NTHREADS + tid, gthreads = G * NTHREADS;
    for (int it = gtid; it < 3072; it += gthreads) {
        if (it < 2048) { const int pos = it >> 5, i = it & 31; const float fr = exp2f(-(float)(2 * i) * (13.287712379549449f / 64.0f)); const float ang = (float)pos * fr;
            const float c = cosf(ang), s = sinf(ang);
            float* t1 = (float*)(ws + WS_TABR) + 2 * (pos * 32 + i); t1[0] = c; t1[1] = s;
            float* t2 = (float*)(ws + WS_TABRT) + 2 * (i * 64 + pos); t2[0] = c; t2[1] = s; }
        else { const int j = it - 2048, pos = j >> 4, i = j & 15; const float fr = exp2f(-(float)(2 * i) * (13.287712379549449f / 32.0f)); const float ang = (float)pos * fr;
            float* t1 = (float*)(ws + WS_TABD) + 2 * (pos * 16 + i); t1[0] = cosf(ang); t1[1] = sinf(ang); }
    }
    for (int i = 0; i < 2; ++i) {
        conv_w((bf16_t*)(ws + WS_WTE) + (size_t)i * 3072 * 1024, A.in[8] + (size_t)i * 1024 * 3072, 3072, 1024, 3072, 0, gtid, gthreads);
        conv_w((bf16_t*)(ws + WS_WTO) + (size_t)i * 4096 * 1024, A.in[13] + (size_t)i * 1024 * 4096, 4096, 1024, 4096, 1, gtid, gthreads);
        conv_w((bf16_t*)(ws + WS_WOT) + (size_t)(2 * i) * 1024 * 1024, A.in[9] + (size_t)i * 1024 * 1024, 1024, 1024, 1024, 2, gtid, gthreads);
        conv_w((bf16_t*)(ws + WS_WOT) + (size_t)(2 * i + 1) * 1024 * 1024, A.in[14] + (size_t)i * 1024 * 1024, 1024, 1024, 1024, 2, gtid, gthreads);
    }
    for (int m = 0; m < 8; ++m) conv_w((bf16_t*)(ws + WS_PWT) + m * 16384, A.in[11] + m * 16384, 128, 128, 128, 2, gtid, gthreads);
}

__device__ __forceinline__ void ew_phase(const Args& A, int l) {
    const int tid = threadIdx.x, lane = tid & 63, wave = tid >> 6;
    unsigned char* ws = A.ws;
    const float* MOD = (const float*)(ws + WS_MOD); const float* Y = (const float*)(ws + WS_P); bf16_t* H = (bf16_t*)(ws + WS_H); float* XC = (float*)(ws + WS_XC);
    for (int R = blockIdx.x * 8 + wave; R < NTOK; R += gridDim.x * 8) {
        const int b = R / SROW, s = R - b * SROW; const bool isctx = s < CTXL;
        if (l == 4 && isctx) continue;
        const int v = isctx ? 32 : b;
        const float* xin; float* xout;
        if (isctx) { const size_t o = ((size_t)b * CTXL + s) * D; xout = XC + o; xin = (l <= 1) ? A.in[2] + o : xout; }
        else { const size_t o = ((size_t)b * SEQ + (s - CTXL)) * D; xout = A.out + o; xin = (l <= 1) ? A.in[0] + o : xout; }
        f32x4 xv[4];
#pragma unroll
        for (int k = 0; k < 4; ++k) xv[k] = *(const f32x4*)(xin + 4 * lane + 256 * k);
        if (l > 0) {
            const float* y = Y + (size_t)R * D; f32x4 yv[4]; float ss = 0.f;
#pragma unroll
            for (int k = 0; k < 4; ++k) { yv[k] = *(const f32x4*)(y + 4 * lane + 256 * k); ss += yv[k][0] * yv[k][0] + yv[k][1] * yv[k][1] + yv[k][2] * yv[k][2] + yv[k][3] * yv[k][3]; }
            ss = wave_sum(ss); const float r = rsqrtf(ss * (1.0f / D) + EPS);
            const float* gate = MOD + (size_t)((l - 1) * 33 + v) * 3072 + 2048; const float* np = A.in[7] + (l - 1) * D;
#pragma unroll
            for (int k = 0; k < 4; ++k) { const f32x4 g = *(const f32x4*)(gate + 4 * lane + 256 * k), n = *(const f32x4*)(np + 4 * lane + 256 * k);
                xv[k] += g * (yv[k] * r * n); *(f32x4*)(xout + 4 * lane + 256 * k) = xv[k]; }
        }
        if (l < 4) {
            float ss = 0.f;
#pragma unroll
            for (int k = 0; k < 4; ++k) ss += xv[k][0] * xv[k][0] + xv[k][1] * xv[k][1] + xv[k][2] * xv[k][2] + xv[k][3] * xv[k][3];
            ss = wave_sum(ss); const float r = rsqrtf(ss * (1.0f / D) + EPS);
            const float* md = MOD + (size_t)(l * 33 + v) * 3072; const float* np = A.in[6] + l * D;
#pragma unroll
            for (int k = 0; k < 4; ++k) { const f32x4 sh = *(const f32x4*)(md + 4 * lane + 256 * k), sc = *(const f32x4*)(md + 1024 + 4 * lane + 256 * k), n = *(const f32x4*)(np + 4 * lane + 256 * k);
                const f32x4 h = xv[k] * r * n * (sc + 1.0f) + sh;
                u32x2 w; w.x = cvt_pk_bf16(h[0], h[1]); w.y = cvt_pk_bf16(h[2], h[3]);
                *(u32x2*)(H + (size_t)R * D + 4 * lane + 256 * k) = w; }
        }
    }
}

constexpr int RP = 272;
__device__ __forceinline__ bf16x8 ld_frag16(LAS const unsigned char* p) { return *(LAS const bf16x8*)p; }
__device__ __forceinline__ bf16x8 ld_frag8x2(LAS const unsigned char* p0, LAS const unsigned char* p1) {
    const u32x2 a = *(LAS const u32x2*)p0, b = *(LAS const u32x2*)p1; u32x4 w; w.x = a.x; w.y = a.y; w.z = b.x; w.w = b.y; return __builtin_bit_cast(bf16x8, w); }

__device__ __forceinline__ void stage128(LAS unsigned char* dst, const bf16_t* src, size_t gp, int tid) {
    u32x4 r[4];
#pragma unroll
    for (int k = 0; k < 4; ++k) { const int q = tid + NTHREADS * k, row = q >> 4, cc = q & 15; r[k] = *(const u32x4*)(src + (size_t)row * gp + cc * 8); }
#pragma unroll
    for (int k = 0; k < 4; ++k) { const int q = tid + NTHREADS * k, row = q >> 4, cc = q & 15; *(LAS u32x4*)(dst + row * RP + cc * 16) = r[k]; }
}

__device__ __forceinline__ void retention_unit(const Args& A, LAS unsigned char* lds, int unit, int li  ) {
    const int tid = threadIdx.x, lane = tid & 63, w = __builtin_amdgcn_readfirstlane(tid >> 6), fr = lane & 15, fq = lane >> 4;
    const int b = unit >> 2, h = unit & 3;
    unsigned char* ws = A.ws;
    const bf16_t* Pn = (const bf16_t*)(ws + WS_P); const bf16_t* T = (const bf16_t*)(ws + WS_T); float* OF = (float*)(ws + WS_OF); bf16_t* A2 = (bf16_t*)(ws + WS_H);
    LAS unsigned char* Ks = lds; LAS unsigned char* Kts = lds + 128 * RP; LAS unsigned char* Vts = lds + 2 * 128 * RP; LAS unsigned char* Ss = lds + 3 * 128 * RP;
    const int iloc = 16 * w + fr;
#pragma unroll 1
    for (int dir = 0; dir < 2; ++dir) {
        const float l2 = -__expf(A.in[10][(li * 2 + dir) * 4 + h]) * 1.4426950408889634f;
        const float cdec = exp2f(l2 * 128.0f);
        const float qd = exp2f(l2 * (dir == 0 ? (float)(iloc + 1) : (float)(128 - iloc)));
        f32x4 accS[8];
#pragma unroll
        for (int dt = 0; dt < 8; ++dt) accS[dt] = (f32x4){0.f, 0.f, 0.f, 0.f};
        __syncthreads();
        for (int q = tid; q < 128 * 16; q += NTHREADS) *(LAS u32x4*)(Ss + (q >> 4) * RP + (q & 15) * 16) = (u32x4){0u, 0u, 0u, 0u};
#pragma unroll 1
        for (int step = 0; step < 18; ++step) {
            const int c = (dir == 0) ? step : (step < 2 ? 1 - step : 19 - step);
            const size_t R0 = (size_t)b * SROW + c * 128;
            float l2v = l2; int fqv = fq, ilv = iloc; asm volatile("" : "+v"(l2v), "+v"(fqv), "+v"(ilv));
            stage128(Ks, Pn + R0 * 2560 + 2048 + h * 128, 2560, tid);
            stage128(Kts, T + (size_t)(h * 128) * NTOK + R0, NTOK, tid);
            stage128(Vts, T + (size_t)(512 + h * 128) * NTOK + R0, NTOK, tid);
            bf16x8 Qf[4];
            { const bf16_t* qp = Pn + (R0 + iloc) * 2560 + h * 128 + 8 * fq;
#pragma unroll
              for (int ds = 0; ds < 4; ++ds) Qf[ds] = *(const bf16x8*)(qp + 32 * ds); }
            __syncthreads();
            f32x4 accO[8];
#pragma unroll
            for (int vt = 0; vt < 8; ++vt) { f32x4 a = {0.f, 0.f, 0.f, 0.f};
#pragma unroll
                for (int ds = 0; ds < 4; ++ds) a = mfma16(ld_frag16(Ss + (16 * vt + fr) * RP + (32 * ds + 8 * fq) * 2), Qf[ds], a);
                accO[vt] = a * qd; }
            bf16x8 PB[4];
#pragma unroll
            for (int jp = 0; jp < 4; ++jp) { float pv[8];
#pragma unroll
                for (int hf = 0; hf < 2; ++hf) { const int jt = 2 * jp + hf; f32x4 sc = {0.f, 0.f, 0.f, 0.f};
#pragma unroll
                    for (int ds = 0; ds < 4; ++ds) sc = mfma16(ld_frag16(Ks + (16 * jt + fr) * RP + (32 * ds + 8 * fq) * 2), Qf[ds], sc);
#pragma unroll
                    for (int r = 0; r < 4; ++r) { const int j = 16 * jt + 4 * fqv + r; const int dlt = (dir == 0) ? (ilv - j) : (j - ilv);
                        const bool keep = (dir == 0) ? (dlt >= 0) : (dlt > 0);
                        pv[4 * hf + r] = keep ? sc[r] * exp2f(l2v * (float)dlt) : 0.f; } }
                u32x4 wv; wv.x = cvt_pk_bf16(pv[0], pv[1]); wv.y = cvt_pk_bf16(pv[2], pv[3]); wv.z = cvt_pk_bf16(pv[4], pv[5]); wv.w = cvt_pk_bf16(pv[6], pv[7]);
                PB[jp] = __builtin_bit_cast(bf16x8, wv); }
#pragma unroll
            for (int vt = 0; vt < 8; ++vt)
#pragma unroll
                for (int jp = 0; jp < 4; ++jp) { LAS const unsigned char* vp = Vts + (16 * vt + fr) * RP + (32 * jp + 4 * fq) * 2;
                    accO[vt] = mfma16(ld_frag8x2(vp, vp + 32), PB[jp], accO[vt]); }
            { float* ofp = OF + (R0 + iloc) * 512 + h * 128 + 4 * fq;
              if (dir == 0) {
#pragma unroll
                  for (int vt = 0; vt < 8; ++vt) *(f32x4*)(ofp + 16 * vt) = accO[vt];
              } else {
                  float s1 = 0.f;
#pragma unroll
                  for (int vt = 0; vt < 8; ++vt) { accO[vt] += *(const f32x4*)(ofp + 16 * vt); s1 += (accO[vt][0] + accO[vt][1]) + (accO[vt][2] + accO[vt][3]); }
                  s1 += __shfl_xor(s1, 16); s1 += __shfl_xor(s1, 32);
                  const float mu = s1 * (1.0f / 128.0f); float s2 = 0.f;
#pragma unroll
                  for (int vt = 0; vt < 8; ++vt) { const f32x4 d = accO[vt] - mu; s2 += (d[0] * d[0] + d[1] * d[1]) + (d[2] * d[2] + d[3] * d[3]); }
                  s2 += __shfl_xor(s2, 16); s2 += __shfl_xor(s2, 32);
                  const float rs = rsqrtf(s2 * (1.0f / 128.0f) + EPS);
                  const bf16_t* gp = Pn + (R0 + iloc) * 2560 + 512 + h * 128 + 4 * fq; bf16_t* op = A2 + (R0 + iloc) * 1024 + h * 128 + 4 * fq;
#pragma unroll
                  for (int vt = 0; vt < 8; ++vt) { const u32x2 g = *(const u32x2*)(gp + 16 * vt);
                      const float o0 = (accO[vt][0] - mu) * rs * silu_f(bflo(g.x)), o1 = (accO[vt][1] - mu) * rs * silu_f(bfhi(g.x));
                      const float o2 = (accO[vt][2] - mu) * rs * silu_f(bflo(g.y)), o3 = (accO[vt][3] - mu) * rs * silu_f(bfhi(g.y));
                      u32x2 wv; wv.x = cvt_pk_bf16(o0, o1); wv.y = cvt_pk_bf16(o2, o3); *(u32x2*)(op + 16 * vt) = wv; }
              } }
            bf16x8 Vd[4];
#pragma unroll
            for (int js = 0; js < 4; ++js) { const u32x4 raw = *(LAS const u32x4*)(Vts + (16 * w + fr) * RP + (32 * js + 8 * fq) * 2); float kd[8];
#pragma unroll
                for (int e = 0; e < 8; ++e) { const int j = 32 * js + 8 * fqv + e; kd[e] = exp2f(l2v * (dir == 0 ? (float)(127 - j) : (float)j)); }
                u32x4 wv; wv.x = cvt_pk_bf16(bflo(raw.x) * kd[0], bfhi(raw.x) * kd[1]); wv.y = cvt_pk_bf16(bflo(raw.y) * kd[2], bfhi(raw.y) * kd[3]);
                wv.z = cvt_pk_bf16(bflo(raw.z) * kd[4], bfhi(raw.z) * kd[5]); wv.w = cvt_pk_bf16(bflo(raw.w) * kd[6], bfhi(raw.w) * kd[7]);
                Vd[js] = __builtin_bit_cast(bf16x8, wv); }
#pragma unroll
            for (int dt = 0; dt < 8; ++dt) { f32x4 a = accS[dt] * cdec;
#pragma unroll
                for (int js = 0; js < 4; ++js) a = mfma16(ld_frag16(Kts + (16 * dt + fr) * RP + (32 * js + 8 * fq) * 2), Vd[js], a);
                accS[dt] = a; }
            __syncthreads();
#pragma unroll
            for (int dt = 0; dt < 8; ++dt) { u32x2 wv; wv.x = cvt_pk_bf16(accS[dt][0], accS[dt][1]); wv.y = cvt_pk_bf16(accS[dt][2], accS[dt][3]);
                *(LAS u32x2*)(Ss + (16 * w + fr) * RP + (16 * dt + 4 * fq) * 2) = wv; }
        }
    }
    __syncthreads();
}

__device__ __forceinline__ void pool_unit(const Args& A, LAS unsigned char* lds, int unit, int li) {
    const int tid = threadIdx.x, lane = tid & 63, w = tid >> 6, fr = lane & 15, fq = lane >> 4;
    const int seg = unit >> 2, g = unit & 3, win = 2 << g, hw = win >> 1;
    unsigned char* ws = A.ws;
    const bf16_t* Pn = (const bf16_t*)(ws + WS_P); bf16_t* A2 = (bf16_t*)(ws + WS_H); const bf16_t* PW = (const bf16_t*)(ws + WS_PWT) + (size_t)(li * 4 + g) * 16384;
    const size_t R0 = (size_t)seg * 128; const int s0 = (int)(R0 % SROW); const bool isctx = s0 < CTXL;
    const int TT = isctx ? CTXL : SEQ, t0 = isctx ? s0 : s0 - CTXL; const size_t Rseq = R0 - t0;
    LAS unsigned char* pin = lds;
    LAS unsigned char* dsm = lds + 144 * RP;
    __syncthreads();
    for (int q = tid; q < 144 * 16; q += NTHREADS) { const int row = q >> 4, cc = q & 15, t = t0 - 8 + row;
        if (t >= 0 && t < TT) *(LAS u32x4*)(pin + row * RP + cc * 16) = *(const u32x4*)(Pn + (Rseq + t) * 2560 + 1024 + g * 128 + cc * 8); }
    __syncthreads();
#pragma unroll
    for (int k = 0; k < 4; ++k) { const int q = tid + NTHREADS * k, tl = q >> 4, cc = q & 15, t = t0 + tl;
        const int lo = max(t - hw, 0), hi = min(t + hw - 1, TT - 1);
        float sm[8];
#pragma unroll
        for (int e = 0; e < 8; ++e) sm[e] = 0.f;
        for (int tt = lo; tt <= hi; ++tt) { const u32x4 r = *(LAS const u32x4*)(pin + (tt - t0 + 8) * RP + cc * 16);
            sm[0] += bflo(r.x); sm[1] += bfhi(r.x); sm[2] += bflo(r.y); sm[3] += bfhi(r.y); sm[4] += bflo(r.z); sm[5] += bfhi(r.z); sm[6] += bflo(r.w); sm[7] += bfhi(r.w); }
        const float inv = 1.0f / (float)(hi - lo + 1);
        const u32x4 c = *(LAS const u32x4*)(pin + (tl + 8) * RP + cc * 16);
        u32x4 wv; wv.x = cvt_pk_bf16(sm[0] * inv - bflo(c.x), sm[1] * inv - bfhi(c.x)); wv.y = cvt_pk_bf16(sm[2] * inv - bflo(c.y), sm[3] * inv - bfhi(c.y));
        wv.z = cvt_pk_bf16(sm[4] * inv - bflo(c.z), sm[5] * inv - bfhi(c.z)); wv.w = cvt_pk_bf16(sm[6] * inv - bflo(c.w), sm[7] * inv - bfhi(c.w));
        *(LAS u32x4*)(dsm + tl * RP + cc * 16) = wv; }
    __syncthreads();
    bf16x8 Bf[4];
#pragma unroll
    for (int cs = 0; cs < 4; ++cs) Bf[cs] = ld_frag16(dsm + (16 * w + fr) * RP + (32 * cs + 8 * fq) * 2);
    const size_t R = R0 + 16 * w + fr;
    const float* psc = A.in[12] + li * 512 + g * 128 + 4 * fq;
    const bf16_t* gp = Pn + R * 2560 + 1536 + g * 128 + 4 * fq; bf16_t* op = A2 + R * 1024 + 512 + g * 128 + 4 * fq;
#pragma unroll
    for (int dt = 0; dt < 8; ++dt) { f32x4 a = {0.f, 0.f, 0.f, 0.f};
#pragma unroll
        for (int cs = 0; cs < 4; ++cs) a = mfma16(*(const bf16x8*)(PW + (16 * dt + fr) * 128 + 32 * cs + 8 * fq), Bf[cs], a);
        const f32x4 sc = *(const f32x4*)(psc + 16 * dt); const u32x2 gg = *(const u32x2*)(gp + 16 * dt);
        u32x2 wv; wv.x = cvt_pk_bf16(a[0] * sc[0] * silu_f(bflo(gg.x)), a[1] * sc[1] * silu_f(bfhi(gg.x))); wv.y = cvt_pk_bf16(a[2] * sc[2] * silu_f(bflo(gg.y)), a[3] * sc[3] * silu_f(bfhi(gg.y)));
        *(u32x2*)(op + 16 * dt) = wv; }
}

#ifdef NO_RET
#define DIS_RET(...)
#else
#define DIS_RET(...) __VA_ARGS__
#endif
#ifdef NO_POOL
#define DIS_POOL(...)
#else
#define DIS_POOL(...) __VA_ARGS__
#endif
__device__ __forceinline__ void even_mixer_phase(const Args& A, LAS unsigned char* lds, int li) {
    const int G = gridDim.x, bx = blockIdx.x;
    const int nret = 128;
    if (G > nret) {
        if (bx < nret) { DIS_RET(retention_unit(A, lds, bx, li);) }
        else for (int u = bx - nret; u < 576 * 4; u += G - nret) { DIS_POOL(pool_unit(A, lds, u, li);) }
    } else {
        for (int u = bx; u < nret; u += G) { DIS_RET(retention_unit(A, lds, u, li);) }
        for (int u = bx; u < 576 * 4; u += G) { DIS_POOL(pool_unit(A, lds, u, li);) }
    }
}

constexpr int KP = 272;
constexpr int VP = 144;
constexpr int KT_BYTES = 64 * KP, VT_BYTES = 128 * VP, ABUF = KT_BYTES + VT_BYTES;

__device__ __forceinline__ void attn_unit(const Args& A, LAS unsigned char* lds, int unit, int l, float lam, float lam_init) {
    const int tid = threadIdx.x, lane = tid & 63, w = __builtin_amdgcn_readfirstlane(tid >> 6), fr = lane & 15, fq = lane >> 4;
    const int li = l >> 1;
    int b, h, qrow0, nkt;
    if (unit < 4096) { const int bh = unit >> 4, qb = unit & 15; b = bh >> 3; h = bh & 7; qrow0 = CTXL + qb * 128; nkt = 36; }
    else { const int u2 = unit - 4096, bh = u2 >> 1, qb = u2 & 1; b = bh >> 3; h = bh & 7; qrow0 = qb * 128; nkt = 4; }
    unsigned char* ws = A.ws;
    const bf16_t* Pn = (const bf16_t*)(ws + WS_P); const bf16_t* T = (const bf16_t*)(ws + WS_T); bf16_t* A2 = (bf16_t*)(ws + WS_H);
    const size_t Rb = (size_t)b * SROW; const size_t Rq = Rb + qrow0 + 16 * w + fr;
    const float cs = 0.125f * 1.4426950408889634f;
    bf16x8 Qf[2][2];
#pragma unroll
    for (int mp = 0; mp < 2; ++mp)
#pragma unroll
        for (int ds = 0; ds < 2; ++ds) Qf[mp][ds] = *(const bf16x8*)(Pn + Rq * 3072 + h * 128 + mp * 64 + 32 * ds + 8 * fq);
    const bf16_t* kbase = Pn + Rb * 3072 + 1024 + h * 128; const bf16_t* vbase = T + (size_t)(h * 128) * NTOK + Rb;
    const int kq0 = tid, kq1 = tid + NTHREADS;
    u32x4 rk[2], rv[2];
#define ATT_LOAD(t) do { const size_t key0 = (size_t)(t) * 64; \
        rk[0] = *(const u32x4*)(kbase + (key0 + (kq0 >> 4)) * 3072 + (kq0 & 15) * 8); rk[1] = *(const u32x4*)(kbase + (key0 + (kq1 >> 4)) * 3072 + (kq1 & 15) * 8); \
        rv[0] = *(const u32x4*)(vbase + (size_t)(kq0 >> 3) * NTOK + key0 + (kq0 & 7) * 8); rv[1] = *(const u32x4*)(vbase + (size_t)(kq1 >> 3) * NTOK + key0 + (kq1 & 7) * 8); } while (0)
#define ATT_STORE(buf) do { LAS unsigned char* kb = lds + (buf) * ABUF; LAS unsigned char* vb = kb + KT_BYTES; \
        *(LAS u32x4*)(kb + (kq0 >> 4) * KP + (kq0 & 15) * 16) = rk[0]; *(LAS u32x4*)(kb + (kq1 >> 4) * KP + (kq1 & 15) * 16) = rk[1]; \
        *(LAS u32x4*)(vb + (kq0 >> 3) * VP + (kq0 & 7) * 16) = rv[0]; *(LAS u32x4*)(vb + (kq1 >> 3) * VP + (kq1 & 7) * 16) = rv[1]; } while (0)
    __syncthreads();
    ATT_LOAD(0); ATT_STORE(0);
    __syncthreads();
    f32x4 acc[2][8];
#pragma unroll
    for (int mp = 0; mp < 2; ++mp)
#pragma unroll
        for (int vt = 0; vt < 8; ++vt) acc[mp][vt] = (f32x4){0.f, 0.f, 0.f, 0.f};
    float mx[2] = {-INFINITY, -INFINITY}, lsum[2] = {0.f, 0.f};
    for (int t = 0; t < nkt; ++t) {
        const int buf = t & 1;
        if (t + 1 < nkt) ATT_LOAD(t + 1);
        LAS const unsigned char* kb = lds + buf * ABUF; LAS const unsigned char* vb = kb + KT_BYTES;
        bf16x8 PB[2][2];
#pragma unroll
        for (int mp = 0; mp < 2; ++mp) {
            f32x4 s[4];
#pragma unroll
            for (int jt = 0; jt < 4; ++jt) { f32x4 a = {0.f, 0.f, 0.f, 0.f};
#pragma unroll
                for (int ds = 0; ds < 2; ++ds) a = mfma16(ld_frag16(kb + (16 * jt + fr) * KP + mp * 128 + (32 * ds + 8 * fq) * 2), Qf[mp][ds], a);
                s[jt] = a; }
            float tm = fmaxf(fmaxf(s[0][0], s[0][1]), fmaxf(s[0][2], s[0][3]));
#pragma unroll
            for (int jt = 1; jt < 4; ++jt) tm = fmaxf(tm, fmaxf(fmaxf(s[jt][0], s[jt][1]), fmaxf(s[jt][2], s[jt][3])));
            tm = fmaxf(tm, __shfl_xor(tm, 16)); tm = fmaxf(tm, __shfl_xor(tm, 32));
            const float mnew = fmaxf(mx[mp], tm);
            const float alpha = exp2f((mx[mp] - mnew) * cs);
            mx[mp] = mnew;
            const float mb = mnew * cs; float ps = 0.f;
#pragma unroll
            for (int jt = 0; jt < 4; ++jt)
#pragma unroll
                for (int r = 0; r < 4; ++r) { const float p = exp2f(s[jt][r] * cs - mb); s[jt][r] = p; ps += p; }
            lsum[mp] = lsum[mp] * alpha + ps;
            if (__any(alpha != 1.0f)) {
#pragma unroll
                for (int vt = 0; vt < 8; ++vt) acc[mp][vt] *= alpha; }
#pragma unroll
            for (int jp = 0; jp < 2; ++jp) { u32x4 wv; wv.x = cvt_pk_bf16(s[2 * jp][0], s[2 * jp][1]); wv.y = cvt_pk_bf16(s[2 * jp][2], s[2 * jp][3]);
                wv.z = cvt_pk_bf16(s[2 * jp + 1][0], s[2 * jp + 1][1]); wv.w = cvt_pk_bf16(s[2 * jp + 1][2], s[2 * jp + 1][3]); PB[mp][jp] = __builtin_bit_cast(bf16x8, wv); }
        }
#pragma unroll
        for (int vt = 0; vt < 8; ++vt)
#pragma unroll
            for (int jp = 0; jp < 2; ++jp) { LAS const unsigned char* vp = vb + (16 * vt + fr) * VP + (32 * jp + 4 * fq) * 2; const bf16x8 vf = ld_frag8x2(vp, vp + 32);
                acc[0][vt] = mfma16(vf, PB[0][jp], acc[0][vt]); acc[1][vt] = mfma16(vf, PB[1][jp], acc[1][vt]); }
        if (t + 1 < nkt) ATT_STORE(buf ^ 1);
        __syncthreads();
    }
#undef ATT_LOAD
#undef ATT_STORE
    float l0 = lsum[0], l1 = lsum[1];
    l0 += __shfl_xor(l0, 16); l0 += __shfl_xor(l0, 32); l1 += __shfl_xor(l1, 16); l1 += __shfl_xor(l1, 32);
    const float i0 = 1.0f / l0, i1 = lam / l1;
    float ss = 0.f;
#pragma unroll
    for (int vt = 0; vt < 8; ++vt) { acc[0][vt] = acc[0][vt] * i0 - acc[1][vt] * i1; ss += (acc[0][vt][0] * acc[0][vt][0] + acc[0][vt][1] * acc[0][vt][1]) + (acc[0][vt][2] * acc[0][vt][2] + acc[0][vt][3] * acc[0][vt][3]); }
    ss += __shfl_xor(ss, 16); ss += __shfl_xor(ss, 32);
    const float rs = rsqrtf(ss * (1.0f / 128.0f) + EPS) * (1.0f - lam_init);
    const float* sub = A.in[16] + li * 128 + 4 * fq; const bf16_t* gp = Pn + Rq * 3072 + 2048 + h * 128 + 4 * fq; bf16_t* op = A2 + Rq * 1024 + h * 128 + 4 * fq;
#pragma unroll
    for (int vt = 0; vt < 8; ++vt) { const f32x4 sb = *(const f32x4*)(sub + 16 * vt); const u32x2 g = *(const u32x2*)(gp + 16 * vt);
        u32x2 wv; wv.x = cvt_pk_bf16(acc[0][vt][0] * rs * sb[0] * silu_f(bflo(g.x)), acc[0][vt][1] * rs * sb[1] * silu_f(bfhi(g.x)));
        wv.y = cvt_pk_bf16(acc[0][vt][2] * rs * sb[2] * silu_f(bflo(g.y)), acc[0][vt][3] * rs * sb[3] * silu_f(bfhi(g.y)));
        *(u32x2*)(op + 16 * vt) = wv; }
}

__device__ __forceinline__ void odd_mixer_phase(const Args& A, LAS unsigned char* lds, int l) {
    const int G = gridDim.x, bx = blockIdx.x, li = l >> 1;
    const float* lp = A.in[15] + li * 256; float d0 = 0.f, d1 = 0.f;
    for (int e = 0; e < 64; ++e) { d0 += lp[e] * lp[64 + e]; d1 += lp[128 + e] * lp[192 + e]; }
    const float lam_init = 0.8f - 0.6f * expf(-0.3f * (float)l);
    const float lam = expf(d0) - expf(d1) + lam_init;
    const int vcu = (G % 8 == 0) ? (bx % 8) * (G / 8) + bx / 8 : bx;
    const int nunits = (l == 3) ? 4096 : 4608;
    for (int u = vcu; u < nunits; u += G) attn_unit(A, lds, u, l, lam, lam_init);
}


#ifdef NO_PRO
#define DIS_PRO(...)
#else
#define DIS_PRO(...) __VA_ARGS__
#endif
#ifdef NO_EW
#define DIS_EW(...)
#else
#define DIS_EW(...) __VA_ARGS__
#endif
#ifdef NO_EVEN
#define DIS_EVEN(...)
#else
#define DIS_EVEN(...) __VA_ARGS__
#endif
#ifdef NO_ODD
#define DIS_ODD(...)
#else
#define DIS_ODD(...) __VA_ARGS__
#endif
#ifdef NO_G1
#define DIS_G1(...)
#else
#define DIS_G1(...) __VA_ARGS__
#endif
#ifdef NO_G2
#define DIS_G2(...)
#else
#define DIS_G2(...) __VA_ARGS__
#endif
#ifdef NO_G3
#define DIS_G3(...)
#else
#define DIS_G3(...) __VA_ARGS__
#endif
template <int PH> __device__ __forceinline__ void run_phase(const Args& A, LAS unsigned char* lds) {
    unsigned char* ws = A.ws;
    const int G = gridDim.x, bx = blockIdx.x;
    if constexpr (PH == 0) { DIS_PRO(prologue_phase(A, lds);) }
    else if constexpr (PH == 1) { DIS_EW(ew_phase(A, 0);) }
    else {
        constexpr int l = (PH - 2) >> 2, sub = (PH - 2) & 3, li = l >> 1;
        const bf16_t* H = (const bf16_t*)(ws + WS_H);
        if constexpr (sub == 0) {
            if constexpr ((l & 1) == 0) {
                const bf16_t* W = (const bf16_t*)(ws + WS_WTE) + (size_t)li * 3072 * 1024;
                { pg8::Gemm g{H, W, NTOK, 2560, 1024}; pg8::StaticOrder S; S.init(NTOK, 2560, G, bx);
                  EpiInNat<0> E{(bf16_t*)(ws + WS_P), 2560, (const f32x4*)(ws + WS_TABR)};
                  DIS_G1(pg8::gemm_phase<EpiInNat<0>, pg8::StaticOrder>(lds, g, S, E, nullptr);) }
                __syncthreads();
                { pg8::Gemm g{W + (size_t)2048 * 1024, H, 1024, NTOK, 1024}; pg8::StaticOrder S; S.init(1024, NTOK, G, bx);
                  EpiSwap<1> E{(bf16_t*)(ws + WS_T), (const float*)(ws + WS_TABRT)};
                  DIS_G2(pg8::gemm_phase<EpiSwap<1>, pg8::StaticOrder>(lds, g, S, E, nullptr);) }
            } else {
                const bf16_t* W = (const bf16_t*)(ws + WS_WTO) + (size_t)li * 4096 * 1024;
                { pg8::Gemm g{H, W, NTOK, 3072, 1024}; pg8::StaticOrder S; S.init(NTOK, 3072, G, bx);
                  EpiInNat<1> E{(bf16_t*)(ws + WS_P), 3072, (const f32x4*)(ws + WS_TABD)};
                  DIS_G1(pg8::gemm_phase<EpiInNat<1>, pg8::StaticOrder>(lds, g, S, E, nullptr);) }
                __syncthreads();
                { pg8::Gemm g{W + (size_t)3072 * 1024, H, 1024, NTOK, 1024}; pg8::StaticOrder S; S.init(1024, NTOK, G, bx);
                  EpiSwap<0> E{(bf16_t*)(ws + WS_T), (const float*)(ws + WS_TABRT)};
                  DIS_G2(pg8::gemm_phase<EpiSwap<0>, pg8::StaticOrder>(lds, g, S, E, nullptr);) }
            }
        } else if constexpr (sub == 1) {
            if constexpr ((l & 1) == 0) { DIS_EVEN(even_mixer_phase(A, lds, li);) } else { DIS_ODD(odd_mixer_phase(A, lds, l);) }
        } else if constexpr (sub == 2) {
            pg8::Gemm g{H, (const bf16_t*)(ws + WS_WOT) + (size_t)l * 1024 * 1024, NTOK, 1024, 1024}; pg8::StaticOrder S; S.init(NTOK, 1024, G, bx);
            EpiF32 E{(float*)(ws + WS_P), 1024};
            DIS_G3(pg8::gemm_phase<EpiF32, pg8::StaticOrder>(lds, g, S, E, nullptr);)
        } else { DIS_EW(ew_phase(A, l + 1);) }
    }
}
__global__ void __launch_bounds__(NTHREADS, 2) mk_fwd(Args A) {
    extern __shared__ __attribute__((aligned(16))) unsigned char lds_raw[];
    LAS unsigned char* lds = (LAS unsigned char*)lds_raw;
    cg::grid_group grid = cg::this_grid();
#define RUN(ph) if (A.ph_lo <= (ph) && (ph) < A.ph_hi) { run_phase<ph>(A, lds); if ((ph) + 1 < A.ph_hi) grid.sync(); }
    RUN(0) RUN(1) RUN(2) RUN(3) RUN(4) RUN(5) RUN(6) RUN(7) RUN(8) RUN(9) RUN(10) RUN(11) RUN(12) RUN(13) RUN(14) RUN(15) RUN(16) RUN(17)
#undef RUN
}

#ifndef MK_MULTI
#define MK_MULTI 0
#endif
constexpr int NPHASES = 18;
extern "C" void kernel_launch(void* const* d_in, const int* in_sizes, int n_in, void* d_out, int out_size, void* d_ws, size_t ws_size, hipStream_t stream) {
    static int grid = 0;
    if (grid == 0) {
        if (n_in != 17 || ws_size < WS_END) { fprintf(stderr, "kernel_launch: unexpected inputs (n_in %d, ws %zu)\n", n_in, ws_size); grid = -1; return; }
        int dev = 0, cus = 0, per_cu = 0;
        hipGetDevice(&dev); hipDeviceGetAttribute(&cus, hipDeviceAttributeMultiprocessorCount, dev);
        if (hipFuncSetAttribute((const void*)mk_fwd, hipFuncAttributeMaxDynamicSharedMemorySize, LDS_BYTES) != hipSuccess) { fprintf(stderr, "kernel_launch: hipFuncSetAttribute failed\n"); grid = -1; return; }
        if (hipOccupancyMaxActiveBlocksPerMultiprocessor(&per_cu, (const void*)mk_fwd, NTHREADS, LDS_BYTES) != hipSuccess || per_cu < 1) { fprintf(stderr, "kernel_launch: occupancy query gave %d\n", per_cu); per_cu = 1; }
        (void)hipGetLastError();
        grid = cus * per_cu;
    }
    if (grid < 0) return;
    Args a{};
    for (int i = 0; i < 17; ++i) a.in[i] = (const float*)d_in[i];
    a.out = (float*)d_out; a.ws = (unsigned char*)d_ws;
#if MK_MULTI
    for (int ph = 0; ph < NPHASES; ++ph) { a.ph_lo = ph; a.ph_hi = ph + 1; hipLaunchKernelGGL(mk_fwd, dim3(grid), dim3(NTHREADS), LDS_BYTES, stream, a); }
#else
    a.ph_lo = 0; a.ph_hi = NPHASES;
    void* args[] = {&a};
    hipError_t e = hipLaunchCooperativeKernel((const void*)mk_fwd, dim3(grid), dim3(NTHREADS), args, LDS_BYTES, stream);
    if (e != hipSuccess) fprintf(stderr, "kernel_launch: cooperative launch failed: %s (grid %d)\n", hipGetErrorString(e), grid);
#endif
}
```

```cpp
#include <hip/hip_runtime.h>
#include <hip/hip_cooperative_groups.h>
#include <cstdio>
#include <cstdint>
namespace cg = cooperative_groups;
namespace pg8 {
#define PG8_LAS __attribute__((address_space(3)))
typedef unsigned short bf16_t;
typedef short bf16x8 __attribute__((ext_vector_type(8)));
typedef float f32x4 __attribute__((ext_vector_type(4)));
typedef unsigned u32x4 __attribute__((ext_vector_type(4)));
constexpr int BM = 256, BK = 64, HALF = 128, HTB = HALF * BK * 2  , STAGE_BYTES = 8 * HTB, NXCD = 8, WGM = 8;

__host__ __device__ __forceinline__ int lds_byte(int r, int c) { const int st = (r >> 4) * 2 + (c >> 5), rr = r & 15, cc = c & 31, ob = rr * 64 + cc * 2; return st * 1024 + (ob ^ (((ob >> 9) & 1) << 5)); }
__host__ __device__ __forceinline__ void stage_rc(int b, int& R, int& C) { const int st = b / 1024, sb = b % 1024, swz = sb ^ (((sb >> 9) & 1) << 5); R = (st >> 1) * 16 + swz / 64; C = (st & 1) * 32 + (swz % 64) / 2; }
__host__ __device__ __forceinline__ int perm32(int rho) { const int n = rho >> 4, i = rho & 15; return 8 * (i >> 2) + 4 * n + (i & 3); }

struct Unit { int pm, pn; };
struct Gemm { const bf16_t* A; const bf16_t* Bt; int M, N, K; };

struct StaticOrder {
    int nM, nN, nwg, G, c;
    __host__ __device__ void init(int M, int N, int G_, int c_) { nM = M / BM; nN = N / BM; nwg = nM * nN; G = G_; c = c_; }
    __host__ __device__ bool next(int i, Unit& u) const {
        const long L = (long)i * G + c; if (L >= nwg) return false;
        int wgid = (int)L; { const int q = nwg / NXCD, r = nwg % NXCD, xcd = wgid % NXCD, off = wgid / NXCD; wgid = (xcd < r ? xcd * (q + 1) : r * (q + 1) + (xcd - r) * q) + off; }
        const int nig = WGM * nN, gid = wgid / nig, fm = gid * WGM, gsz = (nM - fm) < WGM ? (nM - fm) : WGM;
        u.pm = fm + ((wgid % nig) % gsz); u.pn = (wgid % nig) / gsz; return true;
    }
    __device__ __forceinline__ void a_ready(const Unit&) const {}
    __device__ __forceinline__ void done(const Unit&) const {}
};
__device__ __forceinline__ unsigned cvt_pk_bf16(float lo, float hi) { unsigned r; asm volatile("v_cvt_pk_bf16_f32 %0, %1, %2" : "=v"(r) : "v"(lo), "v"(hi)); return r; }
typedef float f32x2 __attribute__((ext_vector_type(2)));
template <class Epi, class Sched, bool STAMP = false>
__device__ __forceinline__ void gemm_phase(PG8_LAS unsigned char* lds, const Gemm g, const Sched& S, const Epi& E, unsigned long long* stamps) {
    const int tid = threadIdx.x, wid = __builtin_amdgcn_readfirstlane(tid >> 6), lane = tid & 63, wr = wid >> 2, wc = wid & 3, fr = lane & 15, fq = lane >> 4;
    const int K = g.K, nt = K / BK;
    int ts_lo = 0, ts_hi = 0, nts = 0; const unsigned long long rt_entry = STAMP ? (unsigned long long)wall_clock64() : 0ull;
#define PG8_STAMP() do { if (STAMP && wid == 0 && nts < 64) { const unsigned long long _c = (unsigned long long)clock64(); \
        ts_lo = (lane == nts) ? (int)(unsigned)_c : ts_lo; ts_hi = (lane == nts) ? (int)(unsigned)(_c >> 32) : ts_hi; ++nts; } } while (0)
    PG8_STAMP();
    unsigned voffA[2], voffB[2];
#pragma unroll
    for (int i = 0; i < 2; ++i) { int R, C; stage_rc(tid * 16 + i * 8192, R, C); const int Rb = Epi::PERM ? ((R & ~31) + perm32(R & 31)) : R;
        voffA[i] = (unsigned)(R * K + C) * 2u; voffB[i] = (unsigned)(Rb * K + C) * 2u; }
    const size_t kstep = (size_t)(BK * 2);
    const size_t hstep = (size_t)HALF * K * 2;
    const size_t tstep = 2 * hstep;
    const unsigned ldsw = (unsigned)wid * 1024u;
    const int aoff = lds_byte(wr * 64 + fr, fq * 8), boff = lds_byte(wc * 32 + fr, fq * 8);
#define PG8_SA(b, h) (((b) * 2 + (h)) * HTB)
#define PG8_SB(b, h) ((4 + (b) * 2 + (h)) * HTB)
#define PG8_STAGE(bufoff, gbase, voff) do { _Pragma("unroll") for (int _i = 0; _i < 2; ++_i) \
        __builtin_amdgcn_global_load_lds((const unsigned*)((const char*)(gbase) + (voff)[_i]), (PG8_LAS unsigned*)(lds + (bufoff) + ldsw + _i * 8192), 16, 0, 0); } while (0)
#define PG8_LDA(dst, b, h) do { _Pragma("unroll") for (int m = 0; m < 4; ++m) _Pragma("unroll") for (int k = 0; k < 2; ++k) dst[m][k] = *(const PG8_LAS bf16x8*)(lds + PG8_SA(b, h) + aoff + m * 2048 + k * 1024); } while (0)
#define PG8_LDB(dst, b, h) do { _Pragma("unroll") for (int n = 0; n < 2; ++n) _Pragma("unroll") for (int k = 0; k < 2; ++k) dst[n][k] = *(const PG8_LAS bf16x8*)(lds + PG8_SB(b, h) + boff + n * 2048 + k * 1024); } while (0)
#define PG8_MMA(ai, bj, At, Bt) do { __builtin_amdgcn_s_setprio(1); _Pragma("unroll") for (int m = 0; m < 4; ++m) _Pragma("unroll") for (int n = 0; n < 2; ++n) _Pragma("unroll") for (int k = 0; k < 2; ++k) \
        acc[ai][bj][m][n] = __builtin_amdgcn_mfma_f32_16x16x32_bf16(Bt[n][k], At[m][k], acc[ai][bj][m][n], 0, 0, 0); __builtin_amdgcn_s_setprio(0); } while (0)
#define PG8_WAIT_V(n) asm volatile("s_waitcnt vmcnt(" #n ")" ::: "memory")
#define PG8_WAIT_L(n) asm volatile("s_waitcnt lgkmcnt(" #n ")" ::: "memory")
#define PG8_BAR __builtin_amdgcn_s_barrier()
#define PG8_SCHED __builtin_amdgcn_sched_barrier(0)
    Unit cur, nxt; int ui = 0;
    if (!S.next(0, cur)) return;
    f32x4 acc[2][2][4][2];
#pragma unroll
    for (int a = 0; a < 2; ++a)
#pragma unroll
        for (int b = 0; b < 2; ++b)
#pragma unroll
            for (int m = 0; m < 4; ++m)
#pragma unroll
                for (int n = 0; n < 2; ++n) acc[a][b][m][n] = (f32x4){0.f, 0.f, 0.f, 0.f};
    bf16x8 At[4][2], B0[2][2], B1[2][2];
    const char* cA = (const char*)g.A + (size_t)cur.pm * tstep; const char* cB = (const char*)g.Bt + (size_t)cur.pn * tstep;
    S.a_ready(cur);
    PG8_STAGE(PG8_SB(0, 0), cB, voffB); PG8_STAGE(PG8_SA(0, 0), cA, voffA); PG8_STAGE(PG8_SB(0, 1), cB + hstep, voffB); PG8_STAGE(PG8_SA(0, 1), cA + hstep, voffA);
    if (wr == 1) PG8_BAR;
    PG8_WAIT_V(4); PG8_BAR;
    PG8_STAGE(PG8_SB(1, 0), cB + kstep, voffB); PG8_STAGE(PG8_SA(1, 0), cA + kstep, voffA); PG8_STAGE(PG8_SB(1, 1), cB + hstep + kstep, voffB);
    PG8_WAIT_V(6); PG8_BAR;
    PG8_STAMP();
    for (;;) {
        const bool has_next = S.next(ui + 1, nxt);
        const char* nA = has_next ? (const char*)g.A + (size_t)nxt.pm * tstep : cA; const char* nB = has_next ? (const char*)g.Bt + (size_t)nxt.pn * tstep : cB;
        for (int t = 0; t < nt; t += 2) {
            const bool last = (t == nt - 2);
            const char* a1 = cA + (size_t)(t + 1) * kstep;
            const char* a2 = last ? nA : cA + (size_t)(t + 2) * kstep; const char* b2 = last ? nB : cB + (size_t)(t + 2) * kstep;
            const char* a3 = a2 + kstep; const char* b3 = b2 + kstep;
            if (last && has_next) S.a_ready(nxt);
            PG8_LDB(B0, 0, 0); PG8_SCHED; PG8_LDA(At, 0, 0); PG8_STAGE(PG8_SA(1, 1), a1 + hstep, voffA);
            PG8_WAIT_L(8); PG8_BAR; PG8_WAIT_L(0); PG8_MMA(0, 0, At, B0); PG8_BAR; PG8_SCHED;
            PG8_LDB(B1, 0, 1); PG8_STAGE(PG8_SB(0, 0), b2, voffB);
            PG8_BAR; PG8_WAIT_L(0); PG8_MMA(0, 1, At, B1); PG8_BAR;
            PG8_LDA(At, 0, 1); PG8_STAGE(PG8_SA(0, 0), a2, voffA);
            PG8_BAR; PG8_WAIT_L(0); PG8_MMA(1, 0, At, B0); PG8_BAR; PG8_SCHED;
            PG8_STAGE(PG8_SB(0, 1), b2 + hstep, voffB);
            PG8_WAIT_V(6); PG8_BAR; PG8_MMA(1, 1, At, B1); PG8_BAR;
            PG8_LDB(B0, 1, 0); PG8_SCHED; PG8_LDA(At, 1, 0); PG8_STAGE(PG8_SA(0, 1), a2 + hstep, voffA);
            PG8_WAIT_L(8); PG8_BAR; PG8_WAIT_L(0); PG8_MMA(0, 0, At, B0); PG8_BAR; PG8_SCHED;
            PG8_LDB(B1, 1, 1); PG8_STAGE(PG8_SB(1, 0), b3, voffB);
            PG8_BAR; PG8_WAIT_L(0); PG8_MMA(0, 1, At, B1); PG8_BAR;
            PG8_LDA(At, 1, 1); PG8_STAGE(PG8_SA(1, 0), a3, voffA);
            PG8_BAR; PG8_WAIT_L(0); PG8_MMA(1, 0, At, B0); PG8_BAR; PG8_SCHED;
            PG8_STAGE(PG8_SB(1, 1), b3 + hstep, voffB);
            PG8_WAIT_V(6); PG8_BAR; PG8_MMA(1, 1, At, B1); PG8_BAR;
        }
        PG8_STAMP();
        if constexpr (!Epi::AFTER_DRAIN) { E(acc, cur, wr, wc, fr, fq); S.done(cur); }
        PG8_STAMP();
        if (!has_next) break;
#pragma unroll
        for (int a = 0; a < 2; ++a)
#pragma unroll
            for (int b = 0; b < 2; ++b)
#pragma unroll
                for (int m = 0; m < 4; ++m)
#pragma unroll
                    for (int n = 0; n < 2; ++n) acc[a][b][m][n] = (f32x4){0.f, 0.f, 0.f, 0.f};
        cur = nxt; cA = nA; cB = nB; ++ui;
    }
    PG8_WAIT_V(0);
    if (wr == 0) PG8_BAR;
    PG8_BAR;
    if constexpr (Epi::AFTER_DRAIN) { E.fused(acc, cur, wr, wc, fr, fq, lds, wid, lane); S.done(cur); }
    PG8_STAMP();
    if (STAMP && wid == 0) { stamps[lane] = lane < nts ? (((unsigned long long)(unsigned)ts_hi << 32) | (unsigned)ts_lo) : 0ull;
        if (lane == 62) stamps[62] = rt_entry; if (lane == 63) stamps[63] = (unsigned long long)wall_clock64(); }
#undef PG8_STAMP
#undef PG8_SA
#undef PG8_SB
#undef PG8_STAGE
#undef PG8_LDA
#undef PG8_LDB
#undef PG8_MMA
#undef PG8_WAIT_V
#undef PG8_WAIT_L
#undef PG8_BAR
#undef PG8_SCHED
}
}

#define LAS __attribute__((address_space(3)))
using pg8::bf16_t; using pg8::bf16x8; using pg8::f32x4; using pg8::u32x4; using pg8::cvt_pk_bf16;
typedef unsigned u32x2 __attribute__((ext_vector_type(2)));
typedef float f32x2v __attribute__((ext_vector_type(2)));

constexpr int D = 1024, NB = 32, SEQ = 2048, CTXL = 256, SROW = 2304, NTOK = NB * SROW;
constexpr float EPS = 1e-6f;
constexpr int NTHREADS = 512;
constexpr int LDS_BYTES = 147456;
constexpr size_t MiB = 1u << 20;
constexpr size_t WS_BAR = 0;
constexpr size_t WS_MOD = 1 * MiB;
constexpr size_t WS_TABR = 3 * MiB;
constexpr size_t WS_TABRT = WS_TABR + 65536;
constexpr size_t WS_TABD = WS_TABRT + 65536;
constexpr size_t WS_WTE = 4 * MiB;
constexpr size_t WS_WTO = 16 * MiB;
constexpr size_t WS_WOT = 32 * MiB;
constexpr size_t WS_PWT = 40 * MiB;
constexpr size_t WS_XC = 48 * MiB;
constexpr size_t WS_H = 80 * MiB;
constexpr size_t WS_P = 224 * MiB;
constexpr size_t WS_T = 656 * MiB;
constexpr size_t WS_OF = 800 * MiB;
constexpr size_t WS_END = 944 * MiB;

struct Args { const float* in[17]; float* out; unsigned char* ws; int ph_lo, ph_hi; };

__device__ __forceinline__ float bf2f(unsigned short u) { return __uint_as_float(((unsigned)u) << 16); }
__device__ __forceinline__ float bflo(unsigned w) { return __uint_as_float(w << 16); }
__device__ __forceinline__ float bfhi(unsigned w) { return __uint_as_float(w & 0xffff0000u); }
__device__ __forceinline__ float silu_f(float x) { return x * __builtin_amdgcn_rcpf(1.0f + __expf(-x)); }
__device__ __forceinline__ f32x4 mfma16(bf16x8 a, bf16x8 b, f32x4 c) { return __builtin_amdgcn_mfma_f32_16x16x32_bf16(a, b, c, 0, 0, 0); }
template <int CTRL> __device__ __forceinline__ float dpp_f(float x) { return __builtin_bit_cast(float, __builtin_amdgcn_mov_dpp(__builtin_bit_cast(int, x), CTRL, 0xf, 0xf, true)); }
__device__ __forceinline__ float wave_sum(float v) {
    v += dpp_f<0xB1>(v);
    v += dpp_f<0x4E>(v);
    v += dpp_f<0x124>(v);
    v += dpp_f<0x128>(v);
    auto s = __builtin_amdgcn_permlane16_swap(__float_as_uint(v), __float_as_uint(v), false, false);
    v = __uint_as_float(s[0]) + __uint_as_float(s[1]);
    auto t = __builtin_amdgcn_permlane32_swap(__float_as_uint(v), __float_as_uint(v), false, false);
    return __uint_as_float(t[0]) + __uint_as_float(t[1]);
}

__device__ __forceinline__ float xrow16_max(float x) {
    auto s = __builtin_amdgcn_permlane16_swap(__float_as_uint(x), __float_as_uint(x), false, false);
    x = fmaxf(__uint_as_float(s[0]), __uint_as_float(s[1]));
    auto t = __builtin_amdgcn_permlane32_swap(__float_as_uint(x), __float_as_uint(x), false, false);
    return fmaxf(__uint_as_float(t[0]), __uint_as_float(t[1]));
}
__device__ __forceinline__ float xrow16_sum(float x) {
    auto s = __builtin_amdgcn_permlane16_swap(__float_as_uint(x), __float_as_uint(x), false, false);
    x = __uint_as_float(s[0]) + __uint_as_float(s[1]);
    auto t = __builtin_amdgcn_permlane32_swap(__float_as_uint(x), __float_as_uint(x), false, false);
    return __uint_as_float(t[0]) + __uint_as_float(t[1]);
}
typedef short s16x4 __attribute__((ext_vector_type(4)));
__device__ __forceinline__ bf16x8 ld_tr8(LAS const unsigned char* p0, LAS const unsigned char* p1) {
    const s16x4 a = __builtin_amdgcn_ds_read_tr16_b64_v4i16((LAS s16x4*)p0), b = __builtin_amdgcn_ds_read_tr16_b64_v4i16((LAS s16x4*)p1);
    return (bf16x8){a[0], a[1], a[2], a[3], b[0], b[1], b[2], b[3]};
}
template <int odd> struct EpiInNat {
    static constexpr bool PERM = true, AFTER_DRAIN = false;
    bf16_t* O; int ldc; const f32x4* tab; bf16_t* KB; bf16_t* VB;
    __device__ __forceinline__ void operator()(const f32x4 (&acc)[2][2][4][2], const pg8::Unit& u, int wr, int wc, int fr, int fq) const {
        const int pn = u.pn;
        const bool latent = (u.pm % 9) != 0;
        bool rope; float scl = 1.0f; int ax, i0, nf;
        if (odd) { rope = latent && pn < 8; ax = wc & 1; i0 = 4 * fq; nf = 16; }
        else { rope = latent && (pn < 2 || pn == 8 || pn == 9); ax = wc >> 1; i0 = 16 * (wc & 1) + 4 * fq; nf = 32; if (pn == 8 || pn == 9) scl = 0.08838834764831845f; }
        const int srow0 = (u.pm % 9) * 256 + wr * 64 + fr;
        const size_t row0 = (size_t)u.pm * 256 + wr * 64 + fr; const int col0 = pn * 256 + wc * 32 + 8 * fq;
        const bool ksec = odd && ((pn >= 4 && pn < 8) || pn >= 12);
        bf16_t* kb0 = (pn >= 12 ? VB : KB) + ((size_t)((u.pm / 9) * 8 + ((pn - 4) & 7) * 2) * SROW) * 128 + wc * 32 + 8 * fq;
        const int colw = (odd && pn >= 8) ? col0 - 1024 : col0;
        const size_t bjs = ksec ? (size_t)SROW * 128 : 128;
#pragma unroll
        for (int ai = 0; ai < 2; ++ai)
#pragma unroll
            for (int m = 0; m < 4; ++m) {
                f32x4 cs0 = {1.f, 0.f, 1.f, 0.f}, cs1 = {1.f, 0.f, 1.f, 0.f};
                if (rope) { const int t = srow0 + ai * 128 + m * 16 - 256; const int pos = ax ? (t & 63) : (t >> 6);
                    const f32x4* tp = tab + ((pos * nf + i0) >> 1); cs0 = tp[0]; cs1 = tp[1]; }
                bf16_t* rowp = ksec ? kb0 + (size_t)(srow0 + ai * 128 + m * 16) * 128 : O + (row0 + ai * 128 + m * 16) * (size_t)ldc + colw;
#pragma unroll
                for (int bj = 0; bj < 2; ++bj) {
                    const f32x4 v0 = acc[ai][bj][m][0], v1 = acc[ai][bj][m][1];
                    const float a0 = (v0[0] * cs0[0] - v0[1] * cs0[1]) * scl, a1 = (v0[0] * cs0[1] + v0[1] * cs0[0]) * scl;
                    const float a2 = (v0[2] * cs0[2] - v0[3] * cs0[3]) * scl, a3 = (v0[2] * cs0[3] + v0[3] * cs0[2]) * scl;
                    const float b0 = (v1[0] * cs1[0] - v1[1] * cs1[1]) * scl, b1 = (v1[0] * cs1[1] + v1[1] * cs1[0]) * scl;
                    const float b2 = (v1[2] * cs1[2] - v1[3] * cs1[3]) * scl, b3 = (v1[2] * cs1[3] + v1[3] * cs1[2]) * scl;
                    u32x4 w; w.x = cvt_pk_bf16(a0, a1); w.y = cvt_pk_bf16(a2, a3); w.z = cvt_pk_bf16(b0, b1); w.w = cvt_pk_bf16(b2, b3);
                    *(u32x4*)(rowp + bj * bjs) = w;
                }
            }
    }
};
struct EpiY16 {
    static constexpr bool PERM = true, AFTER_DRAIN = false;
    bf16_t* C; int ldc;
    __device__ __forceinline__ void operator()(const f32x4 (&acc)[2][2][4][2], const pg8::Unit& u, int wr, int wc, int fr, int fq) const {
        const size_t row0 = (size_t)u.pm * 256 + wr * 64 + fr; const int col0 = u.pn * 256 + wc * 32 + 8 * fq;
#pragma unroll
        for (int ai = 0; ai < 2; ++ai)
#pragma unroll
            for (int m = 0; m < 4; ++m) { bf16_t* rowp = C + (row0 + ai * 128 + m * 16) * (size_t)ldc + col0;
#pragma unroll
                for (int bj = 0; bj < 2; ++bj) { const f32x4 v0 = acc[ai][bj][m][0], v1 = acc[ai][bj][m][1];
                    u32x4 w; w.x = cvt_pk_bf16(v0[0], v0[1]); w.y = cvt_pk_bf16(v0[2], v0[3]); w.z = cvt_pk_bf16(v1[0], v1[1]); w.w = cvt_pk_bf16(v1[2], v1[3]);
                    *(u32x4*)(rowp + bj * 128) = w; } }
    }
};

__device__ __forceinline__ int src_col(int mode, int n) {
    if (mode == 0) {
        const int sec = n >> 9, within = n & 511;
        const int base = (sec == 0) ? 0 : (sec == 1) ? 1536 : (sec == 2) ? 2048 : (sec == 3) ? 2560 : (sec == 4) ? 512 : 1024;
        if (sec == 0 || sec == 4) { const int head = within >> 7, np = within & 127, pp = np >> 1, which = np & 1, a = pp >> 5, i = pp & 31; return base + head * 128 + 64 * a + 32 * which + i; }
        return base + within;
    } else if (mode == 1) {
        const int sec = n >> 10, within = n & 1023;
        const int base = (sec == 0) ? 0 : (sec == 1) ? 1024 : (sec == 2) ? 3072 : 2048;
        if (sec < 2) { const int grp = within >> 6, np = within & 63, pp = np >> 1, which = np & 1, a = pp >> 4, i = pp & 15; return base + grp * 64 + 32 * a + 16 * which + i; }
        return base + within;
    }
    return n;
}
__device__ __forceinline__ void conv_w(bf16_t* dst, const float* src, int nrows, int K, int ld, int mode, int gtid, int gthreads) {
    const int items = nrows * (K >> 3);
    for (int it = gtid; it < items; it += gthreads) {
        const int n = it % nrows, k8 = it / nrows;
        const float* s = src + (size_t)(k8 * 8) * ld + src_col(mode, n);
        float v[8];
#pragma unroll
        for (int e = 0; e < 8; ++e) v[e] = s[(size_t)e * ld];
        u32x4 w; w.x = cvt_pk_bf16(v[0], v[1]); w.y = cvt_pk_bf16(v[2], v[3]); w.z = cvt_pk_bf16(v[4], v[5]); w.w = cvt_pk_bf16(v[6], v[7]);
        *(u32x4*)(dst + (size_t)n * K + k8 * 8) = w;
    }
}

__device__ __forceinline__ void prologue_phase(const Args& A, LAS unsigned char* lds) {
    const int tid = threadIdx.x, lane = tid & 63, wave = tid >> 6, G = gridDim.x, bx = blockIdx.x;
    unsigned char* ws = A.ws;
    float* MOD = (float*)(ws + WS_MOD);
    for (int u = bx; u < 192; u += G) {
        const int l = u / 48, n0 = (u % 48) * 64;
        LAS float* sl = (LAS float*)lds;
        for (int idx = tid; idx < 33 * 1024; idx += NTHREADS) { const int v = idx >> 10, k = idx & 1023; const float x = (v < 32) ? A.in[1][v * 1024 + k] : A.in[3][k]; sl[idx] = silu_f(x); }
        __syncthreads();
        float acc[33];
#pragma unroll
        for (int v = 0; v < 33; ++v) acc[v] = 0.f;
        const float* w = A.in[4] + ((size_t)l * 1024 + wave * 128) * 3072 + n0 + lane;
        for (int kk = 0; kk < 128; ++kk) { const float wv = w[(size_t)kk * 3072]; const int k = wave * 128 + kk;
#pragma unroll
            for (int v = 0; v < 33; ++v) acc[v] += sl[v * 1024 + k] * wv; }
        __syncthreads();
#pragma unroll
        for (int v = 0; v < 33; ++v) sl[(wave * 33 + v) * 64 + lane] = acc[v];
        __syncthreads();
        for (int idx = tid; idx < 33 * 64; idx += NTHREADS) { const int v = idx >> 6, ln = idx & 63; float s = 0.f;
#pragma unroll
            for (int w8 = 0; w8 < 8; ++w8) s += sl[(w8 * 33 + v) * 64 + ln];
            MOD[(size_t)(l * 33 + v) * 3072 + n0 + ln] = s + A.in[5][l * 3072 + n0 + ln]; }
        __syncthreads();
    }
    const int gtid = bx * NTHREADS + tid, gthreads = G * NTHREADS;
    for (int it = gtid; it < 3072; it += gthreads) {
        if (it < 2048) { const int pos = it >> 5, i = it & 31; const float fr = exp2f(-(float)(2 * i) * (13.287712379549449f / 64.0f)); const float ang = (float)pos * fr;
            const float c = cosf(ang), s = sinf(ang);
            float* t1 = (float*)(ws + WS_TABR) + 2 * (pos * 32 + i); t1[0] = c; t1[1] = s;
            float* t2 = (float*)(ws + WS_TABRT) + 2 * (i * 64 + pos); t2[0] = c; t2[1] = s; }
        else { const int j = it - 2048, pos = j >> 4, i = j & 15; const float fr = exp2f(-(float)(2 * i) * (13.287712379549449f / 32.0f)); const float ang = (float)pos * fr;
            float* t1 = (float*)(ws + WS_TABD) + 2 * (pos * 16 + i); t1[0] = cosf(ang); t1[1] = sinf(ang); }
    }
    for (int i = 0; i < 2; ++i) {
        conv_w((bf16_t*)(ws + WS_WTE) + (size_t)i * 3072 * 1024, A.in[8] + (size_t)i * 1024 * 3072, 3072, 1024, 3072, 0, gtid, gthreads);
        conv_w((bf16_t*)(ws + WS_WTO) + (size_t)i * 4096 * 1024, A.in[13] + (size_t)i * 1024 * 4096, 4096, 1024, 4096, 1, gtid, gthreads);
        conv_w((bf16_t*)(ws + WS_WOT) + (size_t)(2 * i) * 1024 * 1024, A.in[9] + (size_t)i * 1024 * 1024, 1024, 1024, 1024, 2, gtid, gthreads);
        conv_w((bf16_t*)(ws + WS_WOT) + (size_t)(2 * i + 1) * 1024 * 1024, A.in[14] + (size_t)i * 1024 * 1024, 1024, 1024, 1024, 2, gtid, gthreads);
    }
    for (int m = 0; m < 8; ++m) conv_w((bf16_t*)(ws + WS_PWT) + m * 16384, A.in[11] + m * 16384, 128, 128, 128, 2, gtid, gthreads);
}

__device__ __forceinline__ void ew_phase(const Args& A, int l) {
    const int tid = threadIdx.x, lane = tid & 63, wave = tid >> 6;
    unsigned char* ws = A.ws;
    const float* MOD = (const float*)(ws + WS_MOD); const bf16_t* Y = (const bf16_t*)(ws + WS_P); bf16_t* H = (bf16_t*)(ws + WS_H); float* XC = (float*)(ws + WS_XC);
    const int nw = gridDim.x * 8;
    constexpr int NR = 4;
    for (int Ra = (blockIdx.x * 8 + wave) * NR; Ra < NTOK; Ra += NR * nw) {
        int Rr[NR]; bool act[NR]; const float* xin[NR]; float* xout[NR]; int vv[NR];
#pragma unroll
        for (int q = 0; q < NR; ++q) Rr[q] = Ra + q;
#pragma unroll
        for (int q = 0; q < NR; ++q) {
            const int R = Rr[q] < NTOK ? Rr[q] : Ra; const int b = R / SROW, s = R - b * SROW; const bool isctx = s < CTXL;
            act[q] = (Rr[q] < NTOK) && !(l == 4 && isctx); Rr[q] = R; vv[q] = isctx ? 32 : b;
            if (isctx) { const size_t o = ((size_t)b * CTXL + s) * D; xout[q] = XC + o; xin[q] = (l <= 1) ? A.in[2] + o : xout[q]; }
            else { const size_t o = ((size_t)b * SEQ + (s - CTXL)) * D; xout[q] = A.out + o; xin[q] = (l <= 1) ? A.in[0] + o : xout[q]; }
        }
        f32x4 xv[NR][4]; u32x2 yr[NR][4];
#pragma unroll
        for (int q = 0; q < NR; ++q)
#pragma unroll
            for (int k = 0; k < 4; ++k) { xv[q][k] = __builtin_nontemporal_load((const f32x4*)(xin[q] + 4 * lane + 256 * k)); if (l > 0) yr[q][k] = __builtin_nontemporal_load((const u32x2*)(Y + (size_t)Rr[q] * D + 4 * lane + 256 * k)); }
#pragma unroll
        for (int q = 0; q < NR; ++q) {
            if (l > 0) {
                f32x4 yv[4]; float ss = 0.f;
#pragma unroll
                for (int k = 0; k < 4; ++k) { yv[k] = (f32x4){bflo(yr[q][k].x), bfhi(yr[q][k].x), bflo(yr[q][k].y), bfhi(yr[q][k].y)}; ss += yv[k][0] * yv[k][0] + yv[k][1] * yv[k][1] + yv[k][2] * yv[k][2] + yv[k][3] * yv[k][3]; }
                ss = wave_sum(ss); const float r = rsqrtf(ss * (1.0f / D) + EPS);
                const float* gate = MOD + (size_t)((l - 1) * 33 + vv[q]) * 3072 + 2048; const float* np = A.in[7] + (l - 1) * D;
#pragma unroll
                for (int k = 0; k < 4; ++k) { const f32x4 g = *(const f32x4*)(gate + 4 * lane + 256 * k), n = *(const f32x4*)(np + 4 * lane + 256 * k);
                    xv[q][k] += g * (yv[k] * r * n); if (act[q]) __builtin_nontemporal_store(xv[q][k], (f32x4*)(xout[q] + 4 * lane + 256 * k)); }
            }
            if (l < 4) {
                float ss = 0.f;
#pragma unroll
                for (int k = 0; k < 4; ++k) ss += xv[q][k][0] * xv[q][k][0] + xv[q][k][1] * xv[q][k][1] + xv[q][k][2] * xv[q][k][2] + xv[q][k][3] * xv[q][k][3];
                ss = wave_sum(ss); const float r = rsqrtf(ss * (1.0f / D) + EPS);
                const float* md = MOD + (size_t)(l * 33 + vv[q]) * 3072; const float* np = A.in[6] + l * D;
#pragma unroll
                for (int k = 0; k < 4; ++k) { const f32x4 sh = *(const f32x4*)(md + 4 * lane + 256 * k), sc = *(const f32x4*)(md + 1024 + 4 * lane + 256 * k), n = *(const f32x4*)(np + 4 * lane + 256 * k);
                    const f32x4 h = xv[q][k] * r * n * (sc + 1.0f) + sh;
                    u32x2 w; w.x = cvt_pk_bf16(h[0], h[1]); w.y = cvt_pk_bf16(h[2], h[3]);
                    if (act[q]) *(u32x2*)(H + (size_t)Rr[q] * D + 4 * lane + 256 * k) = w; }
            }
        }
    }
}

constexpr int RP = 288;
__device__ __forceinline__ bf16x8 ld_frag16(LAS const unsigned char* p) { return *(LAS const bf16x8*)p; }
__device__ __forceinline__ bf16x8 ld_frag8x2(LAS const unsigned char* p0, LAS const unsigned char* p1) {
    const u32x2 a = *(LAS const u32x2*)p0, b = *(LAS const u32x2*)p1; u32x4 w; w.x = a.x; w.y = a.y; w.z = b.x; w.w = b.y; return __builtin_bit_cast(bf16x8, w); }

__device__ __forceinline__ void stage128(LAS unsigned char* dst, const bf16_t* src, size_t gp, int tid) {
    u32x4 r[4];
#pragma unroll
    for (int k = 0; k < 4; ++k) { const int q = tid + NTHREADS * k, row = q >> 4, cc = q & 15; r[k] = *(const u32x4*)(src + (size_t)row * gp + cc * 8); }
#pragma unroll
    for (int k = 0; k < 4; ++k) { const int q = tid + NTHREADS * k, row = q >> 4, cc = q & 15; *(LAS u32x4*)(dst + row * RP + cc * 16) = r[k]; }
}

__device__ __forceinline__ void retention_unit(const Args& A, LAS unsigned char* lds, int unit, int li  ) {
    const int tid = threadIdx.x, lane = tid & 63, w = __builtin_amdgcn_readfirstlane(tid >> 6), fr = lane & 15, fq = lane >> 4;
    const int b = unit >> 2, h = unit & 3;
    unsigned char* ws = A.ws;
    const bf16_t* Pn = (const bf16_t*)(ws + WS_P); float* OF = (float*)(ws + WS_OF); bf16_t* A2 = (bf16_t*)(ws + WS_H);
    LAS unsigned char* Ks = lds; LAS unsigned char* Vs = lds + 128 * RP; LAS unsigned char* Ss = lds + 2 * 128 * RP;
    const int trq = 4 * fq + (fr >> 2), trp = 8 * (fr & 3);
    LAS float* KD = (LAS float*)(lds + 3 * 128 * RP); LAS float* DT = KD + 128;
    { const float l2f_ = -__expf(A.in[10][(li * 2 + 0) * 4 + h]) * 1.4426950408889634f, l2b_ = -__expf(A.in[10][(li * 2 + 1) * 4 + h]) * 1.4426950408889634f;
      __syncthreads();
      for (int e = tid; e < 4 * 264; e += NTHREADS) { const int a = e / 264, m = e - a * 264 + a, dl = 127 - m;
          DT[e] = (dl >= 0) ? exp2f(l2f_ * (float)dl) : exp2f(-l2b_ * (float)dl); } }

    const int iloc = 16 * w + fr;
    LAS const float* dtp = DT + ((127 - iloc) & 3) * 264 + ((127 - iloc) & ~3) + 4 * fq;
#pragma unroll 1
    for (int dir = 0; dir < 2; ++dir) {
        const float l2 = -__expf(A.in[10][(li * 2 + dir) * 4 + h]) * 1.4426950408889634f;
        const float cdec = exp2f(l2 * 128.0f);
        const float qd = exp2f(l2 * (dir == 0 ? (float)(iloc + 1) : (float)(128 - iloc)));
        f32x4 accS[8];
#pragma unroll
        for (int dt = 0; dt < 8; ++dt) accS[dt] = (f32x4){0.f, 0.f, 0.f, 0.f};
        __syncthreads();
        if (tid < 128) KD[tid] = exp2f(l2 * (dir == 0 ? (float)(127 - tid) : (float)tid));
        for (int q = tid; q < 128 * 16; q += NTHREADS) *(LAS u32x4*)(Ss + (q >> 4) * RP + (q & 15) * 16) = (u32x4){0u, 0u, 0u, 0u};
#pragma unroll 1
        for (int step = 0; step < 18; ++step) {
            const int c = (dir == 0) ? step : (step < 2 ? 1 - step : 19 - step);
            const size_t R0 = (size_t)b * SROW + c * 128;
            LAS const float* dtpv = dtp; LAS const float* kdv = KD + 4 * fq; asm volatile("" : "+v"(dtpv), "+v"(kdv));
            bf16x8 Qf[4];
            { u32x4 r0[4], r1[4];
              const bf16_t* s0 = Pn + R0 * 3072 + 2048 + h * 128;
#pragma unroll
              for (int k = 0; k < 4; ++k) { const int q = tid + NTHREADS * k, row = q >> 4, cc = q & 15; r0[k] = *(const u32x4*)(s0 + (size_t)row * 3072 + cc * 8); r1[k] = *(const u32x4*)(s0 + 512 + (size_t)row * 3072 + cc * 8); }
              const bf16_t* qp = Pn + (R0 + iloc) * 3072 + h * 128 + 8 * fq;
#pragma unroll
              for (int ds = 0; ds < 4; ++ds) Qf[ds] = *(const bf16x8*)(qp + 32 * ds);
#pragma unroll
              for (int k = 0; k < 4; ++k) { const int q = tid + NTHREADS * k, row = q >> 4, cc = q & 15; *(LAS u32x4*)(Ks + row * RP + cc * 16) = r0[k]; *(LAS u32x4*)(Vs + row * RP + cc * 16) = r1[k]; } }
            __syncthreads();
            f32x4 accO[8];
#pragma unroll
            for (int hb = 0; hb < 4; ++hb) { bf16x8 fa[8];
#pragma unroll
                for (int q = 0; q < 8; ++q) fa[q] = ld_frag16(Ss + (16 * (2 * hb + (q >> 2)) + fr) * RP + (32 * (q & 3) + 8 * fq) * 2);
                __builtin_amdgcn_sched_barrier(0);
#pragma unroll
                for (int v2 = 0; v2 < 2; ++v2) { f32x4 a = {0.f, 0.f, 0.f, 0.f};
#pragma unroll
                    for (int ds = 0; ds < 4; ++ds) a = mfma16(fa[v2 * 4 + ds], Qf[ds], a);
                    accO[2 * hb + v2] = a * qd; }
                __builtin_amdgcn_sched_barrier(0); }
            if (dir == 1) {
#pragma unroll
            for (int jp = 0; jp < 4; ++jp) { float pv[8];
                bf16x8 fk[8];
#pragma unroll
                for (int q = 0; q < 8; ++q) fk[q] = ld_frag16(Ks + (16 * (2 * jp + (q >> 2)) + fr) * RP + (32 * (q & 3) + 8 * fq) * 2);
                __builtin_amdgcn_sched_barrier(0);
#pragma unroll
                for (int hf = 0; hf < 2; ++hf) { const int jt = 2 * jp + hf; f32x4 sc = {0.f, 0.f, 0.f, 0.f};
#pragma unroll
                    for (int ds = 0; ds < 4; ++ds) sc = mfma16(fk[hf * 4 + ds], Qf[ds], sc);
                    { const f32x4 dw = *(LAS const f32x4*)(dtpv + 16 * jt);
#pragma unroll
                      for (int r = 0; r < 4; ++r) pv[4 * hf + r] = sc[r] * dw[r]; } }
                u32x4 wv; wv.x = cvt_pk_bf16(pv[0], pv[1]); wv.y = cvt_pk_bf16(pv[2], pv[3]); wv.z = cvt_pk_bf16(pv[4], pv[5]); wv.w = cvt_pk_bf16(pv[6], pv[7]);
                const bf16x8 PBj = __builtin_bit_cast(bf16x8, wv);
                bf16x8 fv[8];
#pragma unroll
                for (int vt = 0; vt < 8; ++vt) { LAS const unsigned char* vp = Vs + (32 * jp + trq) * RP + vt * 32 + trp; fv[vt] = ld_tr8(vp, vp + 16 * RP); }
                __builtin_amdgcn_sched_barrier(0);
#pragma unroll
                for (int vt = 0; vt < 8; ++vt) accO[vt] = mfma16(fv[vt], PBj, accO[vt]);
                __builtin_amdgcn_sched_barrier(0); }
            }
            { float* ofp = OF + (R0 + iloc) * 512 + h * 128 + 4 * fq;
              if (dir == 0) {
#pragma unroll
                  for (int vt = 0; vt < 8; ++vt) *(f32x4*)(ofp + 16 * vt) = accO[vt];
              } else {
                  float s1 = 0.f;
#pragma unroll
                  for (int vt = 0; vt < 8; ++vt) { accO[vt] += *(const f32x4*)(ofp + 16 * vt); s1 += (accO[vt][0] + accO[vt][1]) + (accO[vt][2] + accO[vt][3]); }
                  s1 = xrow16_sum(s1);
                  const float mu = s1 * (1.0f / 128.0f); float s2 = 0.f;
#pragma unroll
                  for (int vt = 0; vt < 8; ++vt) { const f32x4 d = accO[vt] - mu; s2 += (d[0] * d[0] + d[1] * d[1]) + (d[2] * d[2] + d[3] * d[3]); }
                  s2 = xrow16_sum(s2);
                  const float rs = rsqrtf(s2 * (1.0f / 128.0f) + EPS);
                  const bf16_t* gp = Pn + (R0 + iloc) * 3072 + 512 + h * 128 + 4 * fq; bf16_t* op = A2 + (R0 + iloc) * 1024 + h * 128 + 4 * fq;
#pragma unroll
                  for (int vt = 0; vt < 8; ++vt) { const u32x2 g = *(const u32x2*)(gp + 16 * vt);
                      const float o0 = (accO[vt][0] - mu) * rs * silu_f(bflo(g.x)), o1 = (accO[vt][1] - mu) * rs * silu_f(bfhi(g.x));
                      const float o2 = (accO[vt][2] - mu) * rs * silu_f(bflo(g.y)), o3 = (accO[vt][3] - mu) * rs * silu_f(bfhi(g.y));
                      u32x2 wv; wv.x = cvt_pk_bf16(o0, o1); wv.y = cvt_pk_bf16(o2, o3); *(u32x2*)(op + 16 * vt) = wv; }
              } }
            bf16x8 Vd[4];
#pragma unroll
            for (int js = 0; js < 4; ++js) { LAS const unsigned char* vp = Vs + (32 * js + trq) * RP + w * 32 + trp; const u32x4 raw = __builtin_bit_cast(u32x4, ld_tr8(vp, vp + 16 * RP)); float kd[8];
                { const f32x4 k0 = *(LAS const f32x4*)(kdv + 32 * js), k1 = *(LAS const f32x4*)(kdv + 32 * js + 16); kd[0] = k0[0]; kd[1] = k0[1]; kd[2] = k0[2]; kd[3] = k0[3]; kd[4] = k1[0]; kd[5] = k1[1]; kd[6] = k1[2]; kd[7] = k1[3]; }
                u32x4 wv; wv.x = cvt_pk_bf16(bflo(raw.x) * kd[0], bfhi(raw.x) * kd[1]); wv.y = cvt_pk_bf16(bflo(raw.y) * kd[2], bfhi(raw.y) * kd[3]);
                wv.z = cvt_pk_bf16(bflo(raw.z) * kd[4], bfhi(raw.z) * kd[5]); wv.w = cvt_pk_bf16(bflo(raw.w) * kd[6], bfhi(raw.w) * kd[7]);
                Vd[js] = __builtin_bit_cast(bf16x8, wv); }
#pragma unroll
            for (int hb = 0; hb < 4; ++hb) { bf16x8 fk[8];
#pragma unroll
                for (int q = 0; q < 8; ++q) { LAS const unsigned char* kp = Ks + (32 * (q & 3) + trq) * RP + (2 * hb + (q >> 2)) * 32 + trp; fk[q] = ld_tr8(kp, kp + 16 * RP); }
                __builtin_amdgcn_sched_barrier(0);
#pragma unroll
                for (int d2 = 0; d2 < 2; ++d2) { f32x4 a = accS[2 * hb + d2] * cdec;
#pragma unroll
                    for (int js = 0; js < 4; ++js) a = mfma16(fk[d2 * 4 + js], Vd[js], a);
                    accS[2 * hb + d2] = a; }
                __builtin_amdgcn_sched_barrier(0); }
            __syncthreads();
#pragma unroll
            for (int dt = 0; dt < 8; ++dt) { u32x2 wv; wv.x = cvt_pk_bf16(accS[dt][0], accS[dt][1]); wv.y = cvt_pk_bf16(accS[dt][2], accS[dt][3]);
                *(LAS u32x2*)(Ss + (16 * w + fr) * RP + (16 * dt + 4 * fq) * 2) = wv; }
        }
    }
    __syncthreads();
}

constexpr int POOL_PIN = 0, POOL_DSM = 144 * RP, POOL_PW = POOL_DSM + 128 * RP;
template <int GI> __device__ __forceinline__ void pool_body(const Args& A, LAS unsigned char* lds, int seg, int li) {
    constexpr int win = 2 << GI, hw = win >> 1, g = GI;
    const int tid = threadIdx.x, lane = tid & 63, w = tid >> 6, fr = lane & 15, fq = lane >> 4;
    unsigned char* ws = A.ws;
    const bf16_t* Pn = (const bf16_t*)(ws + WS_P); bf16_t* A2 = (bf16_t*)(ws + WS_H);
    const size_t R0 = (size_t)seg * 128; const int s0 = (int)(R0 % SROW); const bool isctx = s0 < CTXL;
    const int TT = isctx ? CTXL : SEQ, t0 = isctx ? s0 : s0 - CTXL; const size_t Rseq = R0 - t0;
    LAS unsigned char* pin = lds + POOL_PIN; LAS unsigned char* dsm = lds + POOL_DSM; LAS const unsigned char* PWs = lds + POOL_PW;
    u32x4 rr[5];
#pragma unroll
    for (int k = 0; k < 5; ++k) { const int q = tid + NTHREADS * k, row = q >> 4, cc = q & 15, t = t0 - 8 + row; const bool ok = (q < 144 * 16) && t >= 0 && t < TT;
        rr[k] = (u32x4){0u, 0u, 0u, 0u}; if (ok) rr[k] = *(const u32x4*)(Pn + (Rseq + t) * 3072 + 1024 + g * 128 + cc * 8); }
    const size_t R = R0 + 16 * w + fr;
    const bf16_t* gp = Pn + R * 3072 + 1536 + g * 128 + 4 * fq;
    u32x2 gg[8];
#pragma unroll
    for (int dt = 0; dt < 8; ++dt) gg[dt] = *(const u32x2*)(gp + 16 * dt);
    __syncthreads();
#pragma unroll
    for (int k = 0; k < 5; ++k) { const int q = tid + NTHREADS * k; if (q < 144 * 16) *(LAS u32x4*)(pin + (q >> 4) * RP + (q & 15) * 16) = rr[k]; }
    __syncthreads();
#pragma unroll
    for (int k = 0; k < 4; ++k) { const int q = tid + NTHREADS * k, tl = q >> 4, cc = q & 15, t = t0 + tl;
        const int lo = max(t - hw, 0), hi = min(t + hw - 1, TT - 1);
        float sm[8];
#pragma unroll
        for (int e = 0; e < 8; ++e) sm[e] = 0.f;
#pragma unroll
        for (int ww = 0; ww < win; ++ww) { const u32x4 r = *(LAS const u32x4*)(pin + (tl + 8 - hw + ww) * RP + cc * 16);
            sm[0] += bflo(r.x); sm[1] += bfhi(r.x); sm[2] += bflo(r.y); sm[3] += bfhi(r.y); sm[4] += bflo(r.z); sm[5] += bfhi(r.z); sm[6] += bflo(r.w); sm[7] += bfhi(r.w); }
        const float inv = 1.0f / (float)(hi - lo + 1);
        const u32x4 c = *(LAS const u32x4*)(pin + (tl + 8) * RP + cc * 16);
        u32x4 wv; wv.x = cvt_pk_bf16(sm[0] * inv - bflo(c.x), sm[1] * inv - bfhi(c.x)); wv.y = cvt_pk_bf16(sm[2] * inv - bflo(c.y), sm[3] * inv - bfhi(c.y));
        wv.z = cvt_pk_bf16(sm[4] * inv - bflo(c.z), sm[5] * inv - bfhi(c.z)); wv.w = cvt_pk_bf16(sm[6] * inv - bflo(c.w), sm[7] * inv - bfhi(c.w));
        *(LAS u32x4*)(dsm + tl * RP + cc * 16) = wv; }
    __syncthreads();
    bf16x8 Bf[4];
#pragma unroll
    for (int cs = 0; cs < 4; ++cs) Bf[cs] = ld_frag16(dsm + (16 * w + fr) * RP + (32 * cs + 8 * fq) * 2);
    const float* psc = A.in[12] + li * 512 + g * 128 + 4 * fq;
    bf16_t* op = A2 + R * 1024 + 512 + g * 128 + 4 * fq;
#pragma unroll
    for (int hb = 0; hb < 4; ++hb) { bf16x8 fa[8];
#pragma unroll
        for (int q = 0; q < 8; ++q) fa[q] = ld_frag16(PWs + (16 * (2 * hb + (q >> 2)) + fr) * RP + (32 * (q & 3) + 8 * fq) * 2);
        __builtin_amdgcn_sched_barrier(0);
#pragma unroll
        for (int d2 = 0; d2 < 2; ++d2) { const int dt = 2 * hb + d2; f32x4 a = {0.f, 0.f, 0.f, 0.f};
#pragma unroll
            for (int cs = 0; cs < 4; ++cs) a = mfma16(fa[d2 * 4 + cs], Bf[cs], a);
            const f32x4 sc = *(const f32x4*)(psc + 16 * dt);
            u32x2 wv; wv.x = cvt_pk_bf16(a[0] * sc[0] * silu_f(bflo(gg[dt].x)), a[1] * sc[1] * silu_f(bfhi(gg[dt].x))); wv.y = cvt_pk_bf16(a[2] * sc[2] * silu_f(bflo(gg[dt].y)), a[3] * sc[3] * silu_f(bfhi(gg[dt].y)));
            *(u32x2*)(op + 16 * dt) = wv; }
        __builtin_amdgcn_sched_barrier(0); }
}
__device__ __forceinline__ void pool_stage_w(const Args& A, LAS unsigned char* lds, int g, int li) {
    const bf16_t* PW = (const bf16_t*)(A.ws + WS_PWT) + (size_t)(li * 4 + g) * 16384;
    __syncthreads();
    for (int q = threadIdx.x; q < 128 * 16; q += NTHREADS) *(LAS u32x4*)(lds + POOL_PW + (q >> 4) * RP + (q & 15) * 16) = *(const u32x4*)(PW + q * 8);
    __syncthreads();
}
__device__ __forceinline__ void pool_unit(const Args& A, LAS unsigned char* lds, int unit, int li, int& cur_g) {
    const int seg = unit >> 2, g = unit & 3;
    if (g != cur_g) { pool_stage_w(A, lds, g, li); cur_g = g; }
    switch (g) { case 0: pool_body<0>(A, lds, seg, li); break; case 1: pool_body<1>(A, lds, seg, li); break; case 2: pool_body<2>(A, lds, seg, li); break; default: pool_body<3>(A, lds, seg, li); break; }
}

#ifdef NO_RET
#define DIS_RET(...)
#else
#define DIS_RET(...) __VA_ARGS__
#endif
#ifdef NO_POOL
#define DIS_POOL(...)
#else
#define DIS_POOL(...) __VA_ARGS__
#endif
__device__ __forceinline__ void even_mixer_phase(const Args& A, LAS unsigned char* lds, int li, int part = 0) {
    const int G = gridDim.x, bx = blockIdx.x;
    const int nret = 128; int cur_g = -1;
    if (G > nret) {
        if (bx < nret) { if (part != 2) { DIS_RET(retention_unit(A, lds, bx, li);) } }
        else if (part != 1) for (int u = bx - nret; u < 576 * 4; u += G - nret) { DIS_POOL(pool_unit(A, lds, u, li, cur_g);) }
    } else {
        if (part != 2) for (int u = bx; u < nret; u += G) { DIS_RET(retention_unit(A, lds, u, li);) }
        if (part != 1) for (int u = bx; u < 576 * 4; u += G) { DIS_POOL(pool_unit(A, lds, u, li, cur_g);) }
    }
}

constexpr int KT_BYTES = 64 * 256, VT_BYTES = 64 * 256, AV_OFF = 2 * KT_BYTES;

__device__ __forceinline__ void attn_unit(const Args& A, LAS unsigned char* lds, int unit, int l, float lam, float lam_init) {
    const int tid = threadIdx.x, lane = tid & 63, w = __builtin_amdgcn_readfirstlane(tid >> 6), fr = lane & 15, fq = lane >> 4;
    const int li = l >> 1;
    int b, h, qrow0, nkt;
    if (unit < 4096) { const int bh = unit >> 4, qb = unit & 15; b = bh >> 3; h = bh & 7; qrow0 = CTXL + qb * 128; nkt = 36; }
    else { const int u2 = unit - 4096, bh = u2 >> 1, qb = u2 & 1; b = bh >> 3; h = bh & 7; qrow0 = qb * 128; nkt = 4; }
    unsigned char* ws = A.ws;
    const bf16_t* Pn = (const bf16_t*)(ws + WS_P); bf16_t* A2 = (bf16_t*)(ws + WS_H);
    const size_t Rb = (size_t)b * SROW; const size_t Rq = Rb + qrow0 + 16 * w + fr;
    const float cs = 0.125f * 1.4426950408889634f;
    bf16x8 Qf[2][2];
#pragma unroll
    for (int mp = 0; mp < 2; ++mp)
#pragma unroll
        for (int ds = 0; ds < 2; ++ds) { const u32x4 raw = *(const u32x4*)(Pn + Rq * 2048 + h * 128 + mp * 64 + 32 * ds + 8 * fq); u32x4 wq;
            wq.x = cvt_pk_bf16(bflo(raw.x) * cs, bfhi(raw.x) * cs); wq.y = cvt_pk_bf16(bflo(raw.y) * cs, bfhi(raw.y) * cs); wq.z = cvt_pk_bf16(bflo(raw.z) * cs, bfhi(raw.z) * cs); wq.w = cvt_pk_bf16(bflo(raw.w) * cs, bfhi(raw.w) * cs);
            Qf[mp][ds] = __builtin_bit_cast(bf16x8, wq); }
    const bf16_t* kbase = (const bf16_t*)(ws + WS_OF) + (size_t)(b * 8 + h) * SROW * 128; const bf16_t* vbase = (const bf16_t*)(ws + WS_T) + (size_t)(b * 8 + h) * SROW * 128;
    int ksrc[2], vsrc[2];
#pragma unroll
    for (int i = 0; i < 2; ++i) { const int row = (i * 8 + w) * 4 + (lane >> 4), p = lane & 15; ksrc[i] = row * 128 + (p ^ (row & 15)) * 8; vsrc[i] = row * 128 + (p ^ (2 * (row & 7))) * 8; }
#define ATT_DMA(t, kbuf, vbuf) do { const size_t to_ = (size_t)(t) * 8192; \
        _Pragma("unroll") for (int i_ = 0; i_ < 2; ++i_) { \
            __builtin_amdgcn_global_load_lds((const unsigned*)(kbase + to_ + ksrc[i_]), (LAS unsigned*)(lds + (kbuf) * KT_BYTES + (i_ * 8 + w) * 1024), 16, 0, 0); \
            __builtin_amdgcn_global_load_lds((const unsigned*)(vbase + to_ + vsrc[i_]), (LAS unsigned*)(lds + AV_OFF + (vbuf) * VT_BYTES + (i_ * 8 + w) * 1024), 16, 0, 0); } } while (0)
    int koff[2][2];
#pragma unroll
    for (int mp = 0; mp < 2; ++mp)
#pragma unroll
        for (int ds = 0; ds < 2; ++ds) koff[mp][ds] = fr * 256 + (((mp * 8 + ds * 4 + fq) ^ fr) * 16);
    const int gg32 = (4 * (fq & 1) + (fr >> 2)) * 32;
    const int vlane = (4 * fq + (fr >> 2)) * 256 + ((fr & 3) >> 1) * 16 + (fr & 1) * 8;
    f32x4 acc[2][8];
#pragma unroll
    for (int mp = 0; mp < 2; ++mp)
#pragma unroll
        for (int vt = 0; vt < 8; ++vt) acc[mp][vt] = (f32x4){0.f, 0.f, 0.f, 0.f};
    float lsum[2] = {0.f, 0.f}; f32x4 negm[2] = {{0.f, 0.f, 0.f, 0.f}, {0.f, 0.f, 0.f, 0.f}};
#define ATT_TILE(KOFF, VOFF, first) do { LAS const unsigned char* kb = lds + (KOFF); LAS const unsigned char* vb_ = lds + (VOFF) + vlane; \
        f32x4 s[2][4]; \
        _Pragma("unroll") for (int mp = 0; mp < 2; ++mp) { bf16x8 kf[8]; \
            _Pragma("unroll") for (int q = 0; q < 8; ++q) kf[q] = ld_frag16(kb + (q >> 1) * 4096 + koff[mp][q & 1]); \
            __builtin_amdgcn_sched_barrier(0); \
            _Pragma("unroll") for (int jt = 0; jt < 4; ++jt) s[mp][jt] = mfma16(kf[jt * 2 + 1], Qf[mp][1], mfma16(kf[jt * 2], Qf[mp][0], negm[mp])); \
            __builtin_amdgcn_sched_barrier(0); } \
        bf16x8 PB[2][2]; float ps[2]; \
        _Pragma("unroll") for (int mp = 0; mp < 2; ++mp) { float a_ = 0.f; f32x4 p[4]; \
            _Pragma("unroll") for (int jt = 0; jt < 4; ++jt) _Pragma("unroll") for (int r = 0; r < 4; ++r) { p[jt][r] = __builtin_amdgcn_exp2f(s[mp][jt][r]); a_ += p[jt][r]; } \
            ps[mp] = a_; \
            _Pragma("unroll") for (int jp = 0; jp < 2; ++jp) { u32x4 wv; wv.x = cvt_pk_bf16(p[2 * jp][0], p[2 * jp][1]); wv.y = cvt_pk_bf16(p[2 * jp][2], p[2 * jp][3]); \
                wv.z = cvt_pk_bf16(p[2 * jp + 1][0], p[2 * jp + 1][1]); wv.w = cvt_pk_bf16(p[2 * jp + 1][2], p[2 * jp + 1][3]); PB[mp][jp] = __builtin_bit_cast(bf16x8, wv); } } \
        if ((first) || __any(!(fmaxf(ps[0], ps[1]) < 512.0f))) { \
            _Pragma("unroll") for (int mp = 0; mp < 2; ++mp) { \
                float m_ = fmaxf(fmaxf(s[mp][0][0], s[mp][0][1]), fmaxf(s[mp][0][2], s[mp][0][3])); \
                _Pragma("unroll") for (int jt = 1; jt < 4; ++jt) m_ = fmaxf(fmaxf(m_, s[mp][jt][0]), fmaxf(fmaxf(s[mp][jt][1], s[mp][jt][2]), s[mp][jt][3])); \
                m_ = xrow16_max(m_); \
                const float delta = (first) ? m_ : fmaxf(m_, 0.f); \
                const float alpha = (first) ? 0.f : __builtin_amdgcn_exp2f(-delta); \
                negm[mp] -= delta; lsum[mp] *= alpha; \
                _Pragma("unroll") for (int vt = 0; vt < 8; ++vt) acc[mp][vt] *= alpha; \
                float a_ = 0.f; f32x4 p[4]; \
                _Pragma("unroll") for (int jt = 0; jt < 4; ++jt) _Pragma("unroll") for (int r = 0; r < 4; ++r) { p[jt][r] = __builtin_amdgcn_exp2f(s[mp][jt][r] - delta); a_ += p[jt][r]; } \
                ps[mp] = a_; \
                _Pragma("unroll") for (int jp = 0; jp < 2; ++jp) { u32x4 wv; wv.x = cvt_pk_bf16(p[2 * jp][0], p[2 * jp][1]); wv.y = cvt_pk_bf16(p[2 * jp][2], p[2 * jp][3]); \
                    wv.z = cvt_pk_bf16(p[2 * jp + 1][0], p[2 * jp + 1][1]); wv.w = cvt_pk_bf16(p[2 * jp + 1][2], p[2 * jp + 1][3]); PB[mp][jp] = __builtin_bit_cast(bf16x8, wv); } } \
        } \
        lsum[0] += ps[0]; lsum[1] += ps[1]; \
        _Pragma("unroll") for (int hb_ = 0; hb_ < 2; ++hb_) { bf16x8 vf_[8]; \
            _Pragma("unroll") for (int q_ = 0; q_ < 8; ++q_) { LAS const unsigned char* vp = vb_ + (q_ & 1) * (32 * 256) + (((hb_ * 4 + (q_ >> 1)) * 32) ^ gg32); vf_[q_] = ld_tr8(vp, vp + 16 * 256); } \
            __builtin_amdgcn_sched_barrier(0); \
            _Pragma("unroll") for (int q_ = 0; q_ < 8; ++q_) { acc[0][hb_ * 4 + (q_ >> 1)] = mfma16(vf_[q_], PB[0][q_ & 1], acc[0][hb_ * 4 + (q_ >> 1)]); acc[1][hb_ * 4 + (q_ >> 1)] = mfma16(vf_[q_], PB[1][q_ & 1], acc[1][hb_ * 4 + (q_ >> 1)]); } \
            __builtin_amdgcn_sched_barrier(0); } } while (0)
#define ATT_DMA2(t, KOFF, VOFF) do { const size_t to_ = (size_t)(t) * 8192; \
        _Pragma("unroll") for (int i_ = 0; i_ < 2; ++i_) { \
            __builtin_amdgcn_global_load_lds((const unsigned*)(kbase + to_ + ksrc[i_]), (LAS unsigned*)(lds + (KOFF) + (i_ * 8 + w) * 1024), 16, 0, 0); \
            __builtin_amdgcn_global_load_lds((const unsigned*)(vbase + to_ + vsrc[i_]), (LAS unsigned*)(lds + (VOFF) + (i_ * 8 + w) * 1024), 16, 0, 0); } } while (0)
    __syncthreads();
    ATT_DMA2(0, 0, 16384);
    asm volatile("s_waitcnt vmcnt(0)" ::: "memory");
    __syncthreads();
    const int nit = nkt >> 1;
    if (w >= 4) __builtin_amdgcn_s_setprio(2);
    for (int it = 0; it < nit; ++it) {
        ATT_DMA2(2 * it + 1, 32768, 49152);
        ATT_TILE(0, 16384, it == 0);
        asm volatile("s_waitcnt vmcnt(0)" ::: "memory");
        __syncthreads();
        if (it + 1 < nit) ATT_DMA2(2 * it + 2, 0, 16384);
        ATT_TILE(32768, 49152, false);
        asm volatile("s_waitcnt vmcnt(0)" ::: "memory");
        __syncthreads();
    }
    __builtin_amdgcn_s_setprio(0);
#undef ATT_TILE
#undef ATT_DMA2
#undef ATT_DMA
#undef ATT_PV
    float l0 = lsum[0], l1 = lsum[1];
    l0 = xrow16_sum(l0); l1 = xrow16_sum(l1);
    const float i0 = 1.0f / l0, i1 = lam / l1;
    float ss = 0.f;
#pragma unroll
    for (int vt = 0; vt < 8; ++vt) { acc[0][vt] = acc[0][vt] * i0 - acc[1][vt] * i1; ss += (acc[0][vt][0] * acc[0][vt][0] + acc[0][vt][1] * acc[0][vt][1]) + (acc[0][vt][2] * acc[0][vt][2] + acc[0][vt][3] * acc[0][vt][3]); }
    ss = xrow16_sum(ss);
    const float rs = rsqrtf(ss * (1.0f / 128.0f) + EPS) * (1.0f - lam_init);
    const float* sub = A.in[16] + li * 128 + 4 * fq; const bf16_t* gp = Pn + Rq * 2048 + 1024 + h * 128 + 4 * fq; bf16_t* op = A2 + Rq * 1024 + h * 128 + 4 * fq;
#pragma unroll
    for (int vt = 0; vt < 8; ++vt) { const f32x4 sb = *(const f32x4*)(sub + 16 * vt); const u32x2 g = *(const u32x2*)(gp + 16 * vt);
        u32x2 wv; wv.x = cvt_pk_bf16(acc[0][vt][0] * rs * sb[0] * silu_f(bflo(g.x)), acc[0][vt][1] * rs * sb[1] * silu_f(bfhi(g.x)));
        wv.y = cvt_pk_bf16(acc[0][vt][2] * rs * sb[2] * silu_f(bflo(g.y)), acc[0][vt][3] * rs * sb[3] * silu_f(bfhi(g.y)));
        *(u32x2*)(op + 16 * vt) = wv; }
}

__device__ __forceinline__ void odd_mixer_phase(const Args& A, LAS unsigned char* lds, int l) {
    const int G = gridDim.x, bx = blockIdx.x, li = l >> 1;
    const float* lp = A.in[15] + li * 256; float d0 = 0.f, d1 = 0.f;
    for (int e = 0; e < 64; ++e) { d0 += lp[e] * lp[64 + e]; d1 += lp[128 + e] * lp[192 + e]; }
    const float lam_init = 0.8f - 0.6f * expf(-0.3f * (float)l);
    const float lam = expf(d0) - expf(d1) + lam_init;
    const int vcu = (G % 8 == 0) ? (bx % 8) * (G / 8) + bx / 8 : bx;
    const int nunits = (l == 3) ? 4096 : 4608;
    for (int u = vcu; u < nunits; u += G) attn_unit(A, lds, u, l, lam, lam_init);
}


#define XB_TMO      128
#define XB_XCNT(j)  (256  + 64 * (j))
#define XB_XSUB(j)  (1280 + 64 * (j))
#define XB_XGEN(j)  (2304 + 64 * (j))
#define XB_TOP      3328
#define XB_TOPGEN   3392
#define XCD_BAR_WORDS 3456
#define XB_SPIN_CAP (1u << 18)

__device__ __forceinline__ unsigned xb_ld(unsigned* p)              { return __hip_atomic_load(p, __ATOMIC_RELAXED, __HIP_MEMORY_SCOPE_AGENT); }
__device__ __forceinline__ unsigned xb_add(unsigned* p, unsigned v) { return __hip_atomic_fetch_add(p, v, __ATOMIC_RELAXED, __HIP_MEMORY_SCOPE_AGENT); }
__device__ __forceinline__ unsigned xb_xcc_id() { return (unsigned)__builtin_amdgcn_s_getreg((3 << 11) | 20) & 0xFu; }
#define XB_SPIN(cond, bar) do { unsigned _sp = 0; while (cond) { __builtin_amdgcn_s_sleep(1); \
    if ((++_sp & 255u) == 0u) { if (xb_ld(&(bar)[XB_TMO])) break; if (_sp > XB_SPIN_CAP) { atomicAdd(&(bar)[XB_TMO], 1u); break; } } } } while (0)

struct XcdBarrier {
    unsigned* bar; unsigned x;
    volatile LAS unsigned* st;
};

__device__ __forceinline__ XcdBarrier xcd_barrier_post(unsigned* bar, volatile LAS unsigned* st) {
    XcdBarrier b; b.bar = bar; b.x = xb_xcc_id(); b.st = st;
    if (threadIdx.x == 0) (void)xb_add(&bar[XB_XCNT(b.x)], 1u);
    return b;
}
__device__ __forceinline__ void xcd_barrier_complete(unsigned* bar, unsigned x, unsigned& nloc, unsigned& nx) {
    const unsigned G = gridDim.x * gridDim.y * gridDim.z;
    unsigned sum, cnt, mine, sp = 0u;
    for (;;) {
        sum = 0u; cnt = 0u; mine = 0u;
#pragma unroll
        for (unsigned j = 0; j < 16; ++j) { const unsigned c = xb_ld(&bar[XB_XCNT(j)]); sum += c; cnt += (c > 0u) ? 1u : 0u; mine = (j == x) ? c : mine; }
        if (sum == G) break;
        __builtin_amdgcn_s_sleep(1);
        if ((++sp & 255u) == 0u) { if (xb_ld(&bar[XB_TMO])) break; if (sp > XB_SPIN_CAP) { atomicAdd(&bar[XB_TMO], 1u); break; } }
    }
    nloc = mine > 0u ? mine : 1u; nx = cnt > 0u ? cnt : 1u;
}

__device__ __forceinline__ void xcd_barrier(const XcdBarrier& b) {
    asm volatile("s_waitcnt vmcnt(0)" ::: "memory");
    __syncthreads();
    if (threadIdx.x == 0) {
        unsigned* bar = b.bar;
        __builtin_amdgcn_s_waitcnt(0);
        unsigned nloc = b.st[0], nx = b.st[1];
        if (nloc == 0u) { xcd_barrier_complete(bar, b.x, nloc, nx); b.st[0] = nloc; b.st[1] = nx; }
        const unsigned old = xb_add(&bar[XB_XSUB(b.x)], 1u);
        const unsigned gen = old / nloc;
        if (old + 1u == (gen + 1u) * nloc) {
            __builtin_amdgcn_fence(__ATOMIC_RELEASE, "agent");
            asm volatile("s_waitcnt vmcnt(0)" ::: "memory");
            const unsigned og = xb_add(&bar[XB_TOP], 1u);
            const unsigned tg = og / nx;
            if (og + 1u == (tg + 1u) * nx) xb_add(&bar[XB_TOPGEN], 1u);
            else XB_SPIN(xb_ld(&bar[XB_TOPGEN]) == tg, bar);
            __builtin_amdgcn_fence(__ATOMIC_ACQUIRE, "agent");
            xb_add(&bar[XB_XGEN(b.x)], 1u);
            asm volatile("s_waitcnt vmcnt(0)" ::: "memory");
        } else {
            XB_SPIN(xb_ld(&bar[XB_XGEN(b.x)]) == gen, bar);
            __builtin_amdgcn_fence(__ATOMIC_ACQUIRE, "agent");
            asm volatile("s_waitcnt vmcnt(0)" ::: "memory");
        }
    }
    __syncthreads();
}


#ifdef NO_PRO
#define DIS_PRO(...)
#else
#define DIS_PRO(...) __VA_ARGS__
#endif
#ifdef NO_EW
#define DIS_EW(...)
#else
#define DIS_EW(...) __VA_ARGS__
#endif
#ifdef NO_EVEN
#define DIS_EVEN(...)
#else
#define DIS_EVEN(...) __VA_ARGS__
#endif
#ifdef NO_ODD
#define DIS_ODD(...)
#else
#define DIS_ODD(...) __VA_ARGS__
#endif
#ifdef NO_G1
#define DIS_G1(...)
#else
#define DIS_G1(...) __VA_ARGS__
#endif
#ifdef NO_G2
#define DIS_G2(...)
#else
#define DIS_G2(...) __VA_ARGS__
#endif
#ifdef NO_G3
#define DIS_G3(...)
#else
#define DIS_G3(...) __VA_ARGS__
#endif
template <bool EXTRA> struct TrimOrder : pg8::StaticOrder {
    __device__ void init2(int ncoltiles, int G_, int c_) { init(256 * 256, ncoltiles * 256, G_, c_); }
    __device__ bool next(int i, pg8::Unit& u) const {
        const long L = (long)i * G + c;
        if (L < nwg) { pg8::StaticOrder::next(i, u); u.pm = (u.pm >> 3) * 9 + (u.pm & 7) + 1; return true; }
        if (EXTRA) { const int L2 = (int)(L - nwg); if (L2 >= 256) return false; u.pm = 9 * (L2 >> 3); const int t = L2 & 7; u.pn = t < 4 ? 4 + t : 8 + t; return true; }
        return false;
    }
};
template <int PH> __device__ __forceinline__ void run_phase(const Args& A, LAS unsigned char* lds) {
    unsigned char* ws = A.ws;
    const int G = gridDim.x, bx = blockIdx.x;
    if constexpr (PH == 0) { DIS_PRO(prologue_phase(A, lds);) }
    else if constexpr (PH == 1) { DIS_EW(ew_phase(A, 0);) }
    else {
        constexpr int l = (PH - 2) >> 2, sub = (PH - 2) & 3, li = l >> 1;
        const bf16_t* H = (const bf16_t*)(ws + WS_H);
        if constexpr (sub == 0) {
            if constexpr ((l & 1) == 0) {
                const bf16_t* W = (const bf16_t*)(ws + WS_WTE) + (size_t)li * 3072 * 1024;
                pg8::Gemm g{H, W, NTOK, 3072, 1024}; pg8::StaticOrder S; S.init(NTOK, 3072, G, bx);
                EpiInNat<0> E{(bf16_t*)(ws + WS_P), 3072, (const f32x4*)(ws + WS_TABR), nullptr, nullptr};
                DIS_G1(pg8::gemm_phase<EpiInNat<0>, pg8::StaticOrder>(lds, g, S, E, nullptr);)
            } else {
                const bf16_t* W = (const bf16_t*)(ws + WS_WTO) + (size_t)li * 4096 * 1024;
                pg8::Gemm g{H, W, NTOK, 4096, 1024};
                EpiInNat<1> E{(bf16_t*)(ws + WS_P), 2048, (const f32x4*)(ws + WS_TABD), (bf16_t*)(ws + WS_OF), (bf16_t*)(ws + WS_T)};
                if constexpr (l == 3) { TrimOrder<true> S; S.init2(16, G, bx); DIS_G1(pg8::gemm_phase<EpiInNat<1>, TrimOrder<true>>(lds, g, S, E, nullptr);) }
                else { pg8::StaticOrder S; S.init(NTOK, 4096, G, bx); DIS_G1(pg8::gemm_phase<EpiInNat<1>, pg8::StaticOrder>(lds, g, S, E, nullptr);) }
            }
        } else if constexpr (sub == 1) {
            if constexpr ((l & 1) == 0) { DIS_EVEN(even_mixer_phase(A, lds, li);) } else { DIS_ODD(odd_mixer_phase(A, lds, l);) }
        } else if constexpr (sub == 2) {
            pg8::Gemm g{H, (const bf16_t*)(ws + WS_WOT) + (size_t)l * 1024 * 1024, NTOK, 1024, 1024};
            EpiY16 E{(bf16_t*)(ws + WS_P), 1024};
            if constexpr (l == 3) { TrimOrder<false> S; S.init2(4, G, bx); DIS_G3(pg8::gemm_phase<EpiY16, TrimOrder<false>>(lds, g, S, E, nullptr);) }
            else { pg8::StaticOrder S; S.init(NTOK, 1024, G, bx); DIS_G3(pg8::gemm_phase<EpiY16, pg8::StaticOrder>(lds, g, S, E, nullptr);) }
        } else { DIS_EW(ew_phase(A, l + 1);) }
    }
}
__global__ void __launch_bounds__(NTHREADS, 2) mk_fwd(Args A) {
    extern __shared__ __attribute__((aligned(16))) unsigned char lds_raw[];
    LAS unsigned char* lds = (LAS unsigned char*)lds_raw;
    cg::grid_group grid = cg::this_grid();
    volatile LAS unsigned* bst = (volatile LAS unsigned*)(lds + LDS_BYTES - 64);
    if (threadIdx.x < 2) bst[threadIdx.x] = 0u;
    __syncthreads();
    XcdBarrier xbar = xcd_barrier_post((unsigned*)(A.ws + WS_BAR), bst);
    int nsync = 0;
#ifndef REP_KIND
#define REP_KIND -1
#endif
#define KIND_OF(ph) ((ph) == 0 ? 4 : (ph) == 1 ? 9 : (((ph) - 2) & 3) == 0 ? 0 : (((ph) - 2) & 3) == 2 ? 3 : (((ph) - 2) & 3) == 3 ? 9 : (((((ph) - 2) >> 2) & 1) == 0 ? 1 : 2))
#define RUN(ph) if (A.ph_lo <= (ph) && (ph) < A.ph_hi) { run_phase<ph>(A, lds); if (KIND_OF(ph) == REP_KIND) { __syncthreads(); run_phase<ph>(A, lds); } if (KIND_OF(ph) == 1 && (REP_KIND == 5 || REP_KIND == 6)) { __syncthreads(); even_mixer_phase(A, lds, (((ph) - 2) >> 2) >> 1, REP_KIND - 4); } if ((ph) + 1 < A.ph_hi) { if (A.ph_hi > 1000) grid.sync(); else xcd_barrier(xbar); ++nsync;        if (REP_KIND == 7) { xcd_barrier(xbar); xcd_barrier(xbar); xcd_barrier(xbar); xcd_barrier(xbar); } } }
    RUN(0) RUN(1) RUN(2) RUN(3) RUN(4) RUN(5) RUN(6) RUN(7) RUN(8) RUN(9) RUN(10) RUN(11) RUN(12) RUN(13) RUN(14) RUN(15) RUN(16) RUN(17)
#undef RUN
}

#ifndef MK_MULTI
#define MK_MULTI 0
#endif
constexpr int NPHASES = 18;
extern "C" void kernel_launch(void* const* d_in, const int* in_sizes, int n_in, void* d_out, int out_size, void* d_ws, size_t ws_size, hipStream_t stream) {
    static int grid = 0;
    if (grid == 0) {
        if (n_in != 17 || ws_size < WS_END) { fprintf(stderr, "kernel_launch: unexpected inputs (n_in %d, ws %zu)\n", n_in, ws_size); grid = -1; return; }
        int dev = 0, cus = 0, per_cu = 0;
        hipGetDevice(&dev); hipDeviceGetAttribute(&cus, hipDeviceAttributeMultiprocessorCount, dev);
        if (hipFuncSetAttribute((const void*)mk_fwd, hipFuncAttributeMaxDynamicSharedMemorySize, LDS_BYTES) != hipSuccess) { fprintf(stderr, "kernel_launch: hipFuncSetAttribute failed\n"); grid = -1; return; }
        if (hipOccupancyMaxActiveBlocksPerMultiprocessor(&per_cu, (const void*)mk_fwd, NTHREADS, LDS_BYTES) != hipSuccess || per_cu < 1) { fprintf(stderr, "kernel_launch: occupancy query gave %d\n", per_cu); per_cu = 1; }
        (void)hipGetLastError();
        grid = cus * per_cu;
    }
    if (grid < 0) return;
    if (hipMemsetAsync((char*)d_ws + WS_BAR, 0, 16384, stream) != hipSuccess) { fprintf(stderr, "kernel_launch: memset failed\n"); return; }
    Args a{};
    for (int i = 0; i < 17; ++i) a.in[i] = (const float*)d_in[i];
    a.out = (float*)d_out; a.ws = (unsigned char*)d_ws;
#if MK_MULTI
    for (int ph = 0; ph < NPHASES; ++ph) { a.ph_lo = ph; a.ph_hi = ph + 1; hipLaunchKernelGGL(mk_fwd, dim3(grid), dim3(NTHREADS), LDS_BYTES, stream, a); }
#else
    a.ph_lo = 0; a.ph_hi = NPHASES;
    void* args[] = {&a};
    hipError_t e = hipLaunchCooperativeKernel((const void*)mk_fwd, dim3(grid), dim3(NTHREADS), args, LDS_BYTES, stream);
    if (e != hipSuccess) fprintf(stderr, "kernel_launch: cooperative launch failed: %s (grid %d)\n", hipGetErrorString(e), grid);
#endif
}
```

```cpp
#include <hip/hip_runtime.h>
#include <hip/hip_cooperative_groups.h>
#include <cstdio>
#include <cstdint>
namespace cg = cooperative_groups;
namespace pg8 {
#define PG8_LAS __attribute__((address_space(3)))
typedef unsigned short bf16_t;
typedef short bf16x8 __attribute__((ext_vector_type(8)));
typedef float f32x4 __attribute__((ext_vector_type(4)));
typedef unsigned u32x4 __attribute__((ext_vector_type(4)));
constexpr int BM = 256, BK = 64, HALF = 128, HTB = HALF * BK * 2  , STAGE_BYTES = 8 * HTB, NXCD = 8, WGM = 8;

__host__ __device__ __forceinline__ int lds_byte(int r, int c) { const int st = (r >> 4) * 2 + (c >> 5), rr = r & 15, cc = c & 31, ob = rr * 64 + cc * 2; return st * 1024 + (ob ^ (((ob >> 9) & 1) << 5)); }
__host__ __device__ __forceinline__ void stage_rc(int b, int& R, int& C) { const int st = b / 1024, sb = b % 1024, swz = sb ^ (((sb >> 9) & 1) << 5); R = (st >> 1) * 16 + swz / 64; C = (st & 1) * 32 + (swz % 64) / 2; }
__host__ __device__ __forceinline__ int perm32(int rho) { const int n = rho >> 4, i = rho & 15; return 8 * (i >> 2) + 4 * n + (i & 3); }

struct Unit { int pm, pn; };
struct Gemm { const bf16_t* A; const bf16_t* Bt; int M, N, K; };

struct StaticOrder {
    int nM, nN, nwg, G, c;
    __host__ __device__ void init(int M, int N, int G_, int c_) { nM = M / BM; nN = N / BM; nwg = nM * nN; G = G_; c = c_; }
    __host__ __device__ bool next(int i, Unit& u) const {
        const long L = (long)i * G + c; if (L >= nwg) return false;
        int wgid = (int)L; { const int q = nwg / NXCD, r = nwg % NXCD, xcd = wgid % NXCD, off = wgid / NXCD; wgid = (xcd < r ? xcd * (q + 1) : r * (q + 1) + (xcd - r) * q) + off; }
        const int nig = WGM * nN, gid = wgid / nig, fm = gid * WGM, gsz = (nM - fm) < WGM ? (nM - fm) : WGM;
        u.pm = fm + ((wgid % nig) % gsz); u.pn = (wgid % nig) / gsz; return true;
    }
    __device__ __forceinline__ void a_ready(const Unit&) const {}
    __device__ __forceinline__ void done(const Unit&) const {}
};
__device__ __forceinline__ unsigned cvt_pk_bf16(float lo, float hi) { unsigned r; asm volatile("v_cvt_pk_bf16_f32 %0, %1, %2" : "=v"(r) : "v"(lo), "v"(hi)); return r; }
typedef float f32x2 __attribute__((ext_vector_type(2)));
template <class Epi, class Sched, bool STAMP = false>
__device__ __forceinline__ void gemm_phase(PG8_LAS unsigned char* lds, const Gemm g, const Sched& S, const Epi& E, unsigned long long* stamps) {
    const int tid = threadIdx.x, wid = __builtin_amdgcn_readfirstlane(tid >> 6), lane = tid & 63, wr = wid >> 2, wc = wid & 3, fr = lane & 15, fq = lane >> 4;
    const int K = g.K, nt = K / BK;
    int ts_lo = 0, ts_hi = 0, nts = 0; const unsigned long long rt_entry = STAMP ? (unsigned long long)wall_clock64() : 0ull;
#define PG8_STAMP() do { if (STAMP && wid == 0 && nts < 64) { const unsigned long long _c = (unsigned long long)clock64(); \
        ts_lo = (lane == nts) ? (int)(unsigned)_c : ts_lo; ts_hi = (lane == nts) ? (int)(unsigned)(_c >> 32) : ts_hi; ++nts; } } while (0)
    PG8_STAMP();
    unsigned voffA[2], voffB[2];
#pragma unroll
    for (int i = 0; i < 2; ++i) { int R, C; stage_rc(tid * 16 + i * 8192, R, C); const int Rb = Epi::PERM ? ((R & ~31) + perm32(R & 31)) : R;
        voffA[i] = (unsigned)(R * K + C) * 2u; voffB[i] = (unsigned)(Rb * K + C) * 2u; }
    const size_t kstep = (size_t)(BK * 2);
    const size_t hstep = (size_t)HALF * K * 2;
    const size_t tstep = 2 * hstep;
    const unsigned ldsw = (unsigned)wid * 1024u;
    const int aoff = lds_byte(wr * 64 + fr, fq * 8), boff = lds_byte(wc * 32 + fr, fq * 8);
#define PG8_SA(b, h) (((b) * 2 + (h)) * HTB)
#define PG8_SB(b, h) ((4 + (b) * 2 + (h)) * HTB)
#define PG8_STAGE(bufoff, gbase, voff) do { _Pragma("unroll") for (int _i = 0; _i < 2; ++_i) \
        __builtin_amdgcn_global_load_lds((const unsigned*)((const char*)(gbase) + (voff)[_i]), (PG8_LAS unsigned*)(lds + (bufoff) + ldsw + _i * 8192), 16, 0, 0); } while (0)
#define PG8_LDA(dst, b, h) do { _Pragma("unroll") for (int m = 0; m < 4; ++m) _Pragma("unroll") for (int k = 0; k < 2; ++k) dst[m][k] = *(const PG8_LAS bf16x8*)(lds + PG8_SA(b, h) + aoff + m * 2048 + k * 1024); } while (0)
#define PG8_LDB(dst, b, h) do { _Pragma("unroll") for (int n = 0; n < 2; ++n) _Pragma("unroll") for (int k = 0; k < 2; ++k) dst[n][k] = *(const PG8_LAS bf16x8*)(lds + PG8_SB(b, h) + boff + n * 2048 + k * 1024); } while (0)
#define PG8_MMA(ai, bj, At, Bt) do { __builtin_amdgcn_s_setprio(1); _Pragma("unroll") for (int m = 0; m < 4; ++m) _Pragma("unroll") for (int n = 0; n < 2; ++n) _Pragma("unroll") for (int k = 0; k < 2; ++k) \
        acc[ai][bj][m][n] = __builtin_amdgcn_mfma_f32_16x16x32_bf16(Bt[n][k], At[m][k], acc[ai][bj][m][n], 0, 0, 0); __builtin_amdgcn_s_setprio(0); } while (0)
#define PG8_WAIT_V(n) asm volatile("s_waitcnt vmcnt(" #n ")" ::: "memory")
#define PG8_WAIT_L(n) asm volatile("s_waitcnt lgkmcnt(" #n ")" ::: "memory")
#define PG8_BAR __builtin_amdgcn_s_barrier()
#define PG8_SCHED __builtin_amdgcn_sched_barrier(0)
    Unit cur, nxt; int ui = 0;
    if (!S.next(0, cur)) return;
    f32x4 acc[2][2][4][2];
#pragma unroll
    for (int a = 0; a < 2; ++a)
#pragma unroll
        for (int b = 0; b < 2; ++b)
#pragma unroll
            for (int m = 0; m < 4; ++m)
#pragma unroll
                for (int n = 0; n < 2; ++n) acc[a][b][m][n] = (f32x4){0.f, 0.f, 0.f, 0.f};
    bf16x8 At[4][2], B0[2][2], B1[2][2];
    const char* cA = (const char*)g.A + (size_t)cur.pm * tstep; const char* cB = (const char*)g.Bt + (size_t)cur.pn * tstep;
    S.a_ready(cur);
    PG8_STAGE(PG8_SB(0, 0), cB, voffB); PG8_STAGE(PG8_SA(0, 0), cA, voffA); PG8_STAGE(PG8_SB(0, 1), cB + hstep, voffB); PG8_STAGE(PG8_SA(0, 1), cA + hstep, voffA);
    if (wr == 1) PG8_BAR;
    PG8_WAIT_V(4); PG8_BAR;
    PG8_STAGE(PG8_SB(1, 0), cB + kstep, voffB); PG8_STAGE(PG8_SA(1, 0), cA + kstep, voffA); PG8_STAGE(PG8_SB(1, 1), cB + hstep + kstep, voffB);
    PG8_WAIT_V(6); PG8_BAR;
    PG8_STAMP();
    for (;;) {
        const bool has_next = S.next(ui + 1, nxt);
        const char* nA = has_next ? (const char*)g.A + (size_t)nxt.pm * tstep : cA; const char* nB = has_next ? (const char*)g.Bt + (size_t)nxt.pn * tstep : cB;
        for (int t = 0; t < nt; t += 2) {
            const bool last = (t == nt - 2);
            const char* a1 = cA + (size_t)(t + 1) * kstep;
            const char* a2 = last ? nA : cA + (size_t)(t + 2) * kstep; const char* b2 = last ? nB : cB + (size_t)(t + 2) * kstep;
            const char* a3 = a2 + kstep; const char* b3 = b2 + kstep;
            if (last && has_next) S.a_ready(nxt);
            PG8_LDB(B0, 0, 0); PG8_SCHED; PG8_LDA(At, 0, 0); PG8_STAGE(PG8_SA(1, 1), a1 + hstep, voffA);
            PG8_WAIT_L(8); PG8_BAR; PG8_WAIT_L(0); PG8_MMA(0, 0, At, B0); PG8_BAR; PG8_SCHED;
            PG8_LDB(B1, 0, 1); PG8_STAGE(PG8_SB(0, 0), b2, voffB);
            PG8_BAR; PG8_WAIT_L(0); PG8_MMA(0, 1, At, B1); PG8_BAR;
            PG8_LDA(At, 0, 1); PG8_STAGE(PG8_SA(0, 0), a2, voffA);
            PG8_BAR; PG8_WAIT_L(0); PG8_MMA(1, 0, At, B0); PG8_BAR; PG8_SCHED;
            PG8_STAGE(PG8_SB(0, 1), b2 + hstep, voffB);
            PG8_WAIT_V(6); PG8_BAR; PG8_MMA(1, 1, At, B1); PG8_BAR;
            PG8_LDB(B0, 1, 0); PG8_SCHED; PG8_LDA(At, 1, 0); PG8_STAGE(PG8_SA(0, 1), a2 + hstep, voffA);
            PG8_WAIT_L(8); PG8_BAR; PG8_WAIT_L(0); PG8_MMA(0, 0, At, B0); PG8_BAR; PG8_SCHED;
            PG8_LDB(B1, 1, 1); PG8_STAGE(PG8_SB(1, 0), b3, voffB);
            PG8_BAR; PG8_WAIT_L(0); PG8_MMA(0, 1, At, B1); PG8_BAR;
            PG8_LDA(At, 1, 1); PG8_STAGE(PG8_SA(1, 0), a3, voffA);
            PG8_BAR; PG8_WAIT_L(0); PG8_MMA(1, 0, At, B0); PG8_BAR; PG8_SCHED;
            PG8_STAGE(PG8_SB(1, 1), b3 + hstep, voffB);
            PG8_WAIT_V(6); PG8_BAR; PG8_MMA(1, 1, At, B1); PG8_BAR;
        }
        PG8_STAMP();
        if constexpr (!Epi::AFTER_DRAIN) { E(acc, cur, wr, wc, fr, fq); S.done(cur); }
        PG8_STAMP();
        if (!has_next) break;
#pragma unroll
        for (int a = 0; a < 2; ++a)
#pragma unroll
            for (int b = 0; b < 2; ++b)
#pragma unroll
                for (int m = 0; m < 4; ++m)
#pragma unroll
                    for (int n = 0; n < 2; ++n) acc[a][b][m][n] = (f32x4){0.f, 0.f, 0.f, 0.f};
        cur = nxt; cA = nA; cB = nB; ++ui;
    }
    PG8_WAIT_V(0);
    if (wr == 0) PG8_BAR;
    PG8_BAR;
    if constexpr (Epi::AFTER_DRAIN) { E.fused(acc, cur, wr, wc, fr, fq, lds, wid, lane); S.done(cur); }
    PG8_STAMP();
    if (STAMP && wid == 0) { stamps[lane] = lane < nts ? (((unsigned long long)(unsigned)ts_hi << 32) | (unsigned)ts_lo) : 0ull;
        if (lane == 62) stamps[62] = rt_entry; if (lane == 63) stamps[63] = (unsigned long long)wall_clock64(); }
#undef PG8_STAMP
#undef PG8_SA
#undef PG8_SB
#undef PG8_STAGE
#undef PG8_LDA
#undef PG8_LDB
#undef PG8_MMA
#undef PG8_WAIT_V
#undef PG8_WAIT_L
#undef PG8_BAR
#undef PG8_SCHED
}
}

#define LAS __attribute__((address_space(3)))
using pg8::bf16_t; using pg8::bf16x8; using pg8::f32x4; using pg8::u32x4; using pg8::cvt_pk_bf16;
typedef unsigned u32x2 __attribute__((ext_vector_type(2)));
typedef float f32x2v __attribute__((ext_vector_type(2)));

constexpr int D = 1024, NB = 32, SEQ = 2048, CTXL = 256, SROW = 2304, NTOK = NB * SROW;
constexpr float EPS = 1e-6f;
constexpr int NTHREADS = 512;
constexpr int LDS_BYTES = 147456;
constexpr size_t MiB = 1u << 20;
constexpr size_t WS_BAR = 0;
constexpr size_t WS_MOD = 1 * MiB;
constexpr size_t WS_TABR = 3 * MiB;
constexpr size_t WS_TABRT = WS_TABR + 65536;
constexpr size_t WS_TABD = WS_TABRT + 65536;
constexpr size_t WS_WTE = 4 * MiB;
constexpr size_t WS_WTO = 16 * MiB;
constexpr size_t WS_WOT = 32 * MiB;
constexpr size_t WS_PWT = 40 * MiB;
constexpr size_t WS_XC = 48 * MiB;
constexpr size_t WS_H = 80 * MiB;
constexpr size_t WS_P = 224 * MiB;
constexpr size_t WS_T = 656 * MiB;
constexpr size_t WS_OF = 800 * MiB;
constexpr size_t WS_END = 944 * MiB;

struct Args { const float* in[17]; float* out; unsigned char* ws; int ph_lo, ph_hi; };

__device__ __forceinline__ float bf2f(unsigned short u) { return __uint_as_float(((unsigned)u) << 16); }
__device__ __forceinline__ float bflo(unsigned w) { return __uint_as_float(w << 16); }
__device__ __forceinline__ float bfhi(unsigned w) { return __uint_as_float(w & 0xffff0000u); }
__device__ __forceinline__ float silu_f(float x) { return x * __builtin_amdgcn_rcpf(1.0f + __expf(-x)); }
__device__ __forceinline__ f32x4 mfma16(bf16x8 a, bf16x8 b, f32x4 c) { return __builtin_amdgcn_mfma_f32_16x16x32_bf16(a, b, c, 0, 0, 0); }
template <int CTRL> __device__ __forceinline__ float dpp_f(float x) { return __builtin_bit_cast(float, __builtin_amdgcn_mov_dpp(__builtin_bit_cast(int, x), CTRL, 0xf, 0xf, true)); }
__device__ __forceinline__ float wave_sum(float v) {
    v += dpp_f<0xB1>(v);
    v += dpp_f<0x4E>(v);
    v += dpp_f<0x124>(v);
    v += dpp_f<0x128>(v);
    auto s = __builtin_amdgcn_permlane16_swap(__float_as_uint(v), __float_as_uint(v), false, false);
    v = __uint_as_float(s[0]) + __uint_as_float(s[1]);
    auto t = __builtin_amdgcn_permlane32_swap(__float_as_uint(v), __float_as_uint(v), false, false);
    return __uint_as_float(t[0]) + __uint_as_float(t[1]);
}

__device__ __forceinline__ float xrow16_max(float x) {
    auto s = __builtin_amdgcn_permlane16_swap(__float_as_uint(x), __float_as_uint(x), false, false);
    x = fmaxf(__uint_as_float(s[0]), __uint_as_float(s[1]));
    auto t = __builtin_amdgcn_permlane32_swap(__float_as_uint(x), __float_as_uint(x), false, false);
    return fmaxf(__uint_as_float(t[0]), __uint_as_float(t[1]));
}
__device__ __forceinline__ float xrow16_sum(float x) {
    auto s = __builtin_amdgcn_permlane16_swap(__float_as_uint(x), __float_as_uint(x), false, false);
    x = __uint_as_float(s[0]) + __uint_as_float(s[1]);
    auto t = __builtin_amdgcn_permlane32_swap(__float_as_uint(x), __float_as_uint(x), false, false);
    return __uint_as_float(t[0]) + __uint_as_float(t[1]);
}
typedef short s16x4 __attribute__((ext_vector_type(4)));
__device__ __forceinline__ bf16x8 ld_tr8(LAS const unsigned char* p0, LAS const unsigned char* p1) {
    const s16x4 a = __builtin_amdgcn_ds_read_tr16_b64_v4i16((LAS s16x4*)p0), b = __builtin_amdgcn_ds_read_tr16_b64_v4i16((LAS s16x4*)p1);
    return (bf16x8){a[0], a[1], a[2], a[3], b[0], b[1], b[2], b[3]};
}
template <int odd> struct EpiInNat {
    static constexpr bool PERM = true, AFTER_DRAIN = false;
    bf16_t* O; int ldc; const f32x4* tab; bf16_t* KB; bf16_t* VB;
    __device__ __forceinline__ void operator()(const f32x4 (&acc)[2][2][4][2], const pg8::Unit& u, int wr, int wc, int fr, int fq) const {
        const int pn = u.pn;
        const bool latent = (u.pm % 9) != 0;
        bool rope; float scl = 1.0f; int ax, i0, nf;
        if (odd) { rope = latent && pn < 8; ax = wc & 1; i0 = 4 * fq; nf = 16; }
        else { rope = latent && (pn < 2 || pn == 8 || pn == 9); ax = wc >> 1; i0 = 16 * (wc & 1) + 4 * fq; nf = 32; if (pn == 8 || pn == 9) scl = 0.08838834764831845f; }
        float frv[4];
#pragma unroll
        for (int e = 0; e < 4; ++e) frv[e] = exp2f(-(float)(2 * (i0 + e)) * (13.287712379549449f / (float)(2 * nf))) * 0.15915494309189535f;
        const int srow0 = (u.pm % 9) * 256 + wr * 64 + fr;
        const size_t row0 = (size_t)u.pm * 256 + wr * 64 + fr; const int col0 = pn * 256 + wc * 32 + 8 * fq;
        const bool ksec = odd && ((pn >= 4 && pn < 8) || pn >= 12);
        bf16_t* kb0 = (pn >= 12 ? VB : KB) + ((size_t)((u.pm / 9) * 8 + ((pn - 4) & 7) * 2) * SROW) * 128 + wc * 32 + 8 * fq;
        const int colw = (odd && pn >= 8) ? col0 - 1024 : col0;
        const size_t bjs = ksec ? (size_t)SROW * 128 : 128;
#pragma unroll
        for (int ai = 0; ai < 2; ++ai)
#pragma unroll
            for (int m = 0; m < 4; ++m) {
                f32x4 cs0 = {1.f, 0.f, 1.f, 0.f}, cs1 = {1.f, 0.f, 1.f, 0.f};
                if (rope) { const int t = srow0 + ai * 128 + m * 16 - 256; const float pos = (float)(ax ? (t & 63) : (t >> 6));
                    const float r0 = __builtin_amdgcn_fractf(pos * frv[0]), r1 = __builtin_amdgcn_fractf(pos * frv[1]), r2 = __builtin_amdgcn_fractf(pos * frv[2]), r3 = __builtin_amdgcn_fractf(pos * frv[3]);
                    cs0 = (f32x4){__builtin_amdgcn_cosf(r0), __builtin_amdgcn_sinf(r0), __builtin_amdgcn_cosf(r1), __builtin_amdgcn_sinf(r1)};
                    cs1 = (f32x4){__builtin_amdgcn_cosf(r2), __builtin_amdgcn_sinf(r2), __builtin_amdgcn_cosf(r3), __builtin_amdgcn_sinf(r3)}; }
                bf16_t* rowp = ksec ? kb0 + (size_t)(srow0 + ai * 128 + m * 16) * 128 : O + (row0 + ai * 128 + m * 16) * (size_t)ldc + colw;
#pragma unroll
                for (int bj = 0; bj < 2; ++bj) {
                    const f32x4 v0 = acc[ai][bj][m][0], v1 = acc[ai][bj][m][1];
                    const float a0 = (v0[0] * cs0[0] - v0[1] * cs0[1]) * scl, a1 = (v0[0] * cs0[1] + v0[1] * cs0[0]) * scl;
                    const float a2 = (v0[2] * cs0[2] - v0[3] * cs0[3]) * scl, a3 = (v0[2] * cs0[3] + v0[3] * cs0[2]) * scl;
                    const float b0 = (v1[0] * cs1[0] - v1[1] * cs1[1]) * scl, b1 = (v1[0] * cs1[1] + v1[1] * cs1[0]) * scl;
                    const float b2 = (v1[2] * cs1[2] - v1[3] * cs1[3]) * scl, b3 = (v1[2] * cs1[3] + v1[3] * cs1[2]) * scl;
                    u32x4 w; w.x = cvt_pk_bf16(a0, a1); w.y = cvt_pk_bf16(a2, a3); w.z = cvt_pk_bf16(b0, b1); w.w = cvt_pk_bf16(b2, b3);
                    *(u32x4*)(rowp + bj * bjs) = w;
                }
            }
    }
};
struct EpiY16 {
    static constexpr bool PERM = true, AFTER_DRAIN = false;
    bf16_t* C; int ldc;
    __device__ __forceinline__ void operator()(const f32x4 (&acc)[2][2][4][2], const pg8::Unit& u, int wr, int wc, int fr, int fq) const {
        const size_t row0 = (size_t)u.pm * 256 + wr * 64 + fr; const int col0 = u.pn * 256 + wc * 32 + 8 * fq;
#pragma unroll
        for (int ai = 0; ai < 2; ++ai)
#pragma unroll
            for (int m = 0; m < 4; ++m) { bf16_t* rowp = C + (row0 + ai * 128 + m * 16) * (size_t)ldc + col0;
#pragma unroll
                for (int bj = 0; bj < 2; ++bj) { const f32x4 v0 = acc[ai][bj][m][0], v1 = acc[ai][bj][m][1];
                    u32x4 w; w.x = cvt_pk_bf16(v0[0], v0[1]); w.y = cvt_pk_bf16(v0[2], v0[3]); w.z = cvt_pk_bf16(v1[0], v1[1]); w.w = cvt_pk_bf16(v1[2], v1[3]);
                    *(u32x4*)(rowp + bj * 128) = w; } }
    }
};

__device__ __forceinline__ int src_col(int mode, int n) {
    if (mode == 0) {
        const int sec = n >> 9, within = n & 511;
        const int base = (sec == 0) ? 0 : (sec == 1) ? 1536 : (sec == 2) ? 2048 : (sec == 3) ? 2560 : (sec == 4) ? 512 : 1024;
        if (sec == 0 || sec == 4) { const int head = within >> 7, np = within & 127, pp = np >> 1, which = np & 1, a = pp >> 5, i = pp & 31; return base + head * 128 + 64 * a + 32 * which + i; }
        return base + within;
    } else if (mode == 1) {
        const int sec = n >> 10, within = n & 1023;
        const int base = (sec == 0) ? 0 : (sec == 1) ? 1024 : (sec == 2) ? 3072 : 2048;
        if (sec < 2) { const int grp = within >> 6, np = within & 63, pp = np >> 1, which = np & 1, a = pp >> 4, i = pp & 15; return base + grp * 64 + 32 * a + 16 * which + i; }
        return base + within;
    }
    return n;
}
__device__ __forceinline__ void conv_w(bf16_t* dst, const float* src, int nrows, int K, int ld, int mode, int gtid, int gthreads) {
    const int items = nrows * (K >> 3);
    for (int it = gtid; it < items; it += gthreads) {
        const int n = it % nrows, k8 = it / nrows;
        const float* s = src + (size_t)(k8 * 8) * ld + src_col(mode, n);
        float v[8];
#pragma unroll
        for (int e = 0; e < 8; ++e) v[e] = s[(size_t)e * ld];
        u32x4 w; w.x = cvt_pk_bf16(v[0], v[1]); w.y = cvt_pk_bf16(v[2], v[3]); w.z = cvt_pk_bf16(v[4], v[5]); w.w = cvt_pk_bf16(v[6], v[7]);
        *(u32x4*)(dst + (size_t)n * K + k8 * 8) = w;
    }
}

__device__ __forceinline__ void prologue_phase(const Args& A, LAS unsigned char* lds) {
    const int tid = threadIdx.x, lane = tid & 63, wave = tid >> 6, G = gridDim.x, bx = blockIdx.x;
    unsigned char* ws = A.ws;
    float* MOD = (float*)(ws + WS_MOD);
    for (int u = bx; u < 192; u += G) {
        const int l = u / 48, n0 = (u % 48) * 64;
        LAS float* sl = (LAS float*)lds;
        for (int idx = tid; idx < 33 * 1024; idx += NTHREADS) { const int v = idx >> 10, k = idx & 1023; const float x = (v < 32) ? A.in[1][v * 1024 + k] : A.in[3][k]; sl[idx] = silu_f(x); }
        __syncthreads();
        float acc[33];
#pragma unroll
        for (int v = 0; v < 33; ++v) acc[v] = 0.f;
        const float* w = A.in[4] + ((size_t)l * 1024 + wave * 128) * 3072 + n0 + lane;
        for (int kk = 0; kk < 128; ++kk) { const float wv = w[(size_t)kk * 3072]; const int k = wave * 128 + kk;
#pragma unroll
            for (int v = 0; v < 33; ++v) acc[v] += sl[v * 1024 + k] * wv; }
        __syncthreads();
#pragma unroll
        for (int v = 0; v < 33; ++v) sl[(wave * 33 + v) * 64 + lane] = acc[v];
        __syncthreads();
        for (int idx = tid; idx < 33 * 64; idx += NTHREADS) { const int v = idx >> 6, ln = idx & 63; float s = 0.f;
#pragma unroll
            for (int w8 = 0; w8 < 8; ++w8) s += sl[(w8 * 33 + v) * 64 + ln];
            MOD[(size_t)(l * 33 + v) * 3072 + n0 + ln] = s + A.in[5][l * 3072 + n0 + ln]; }
        __syncthreads();
    }
    const int gtid = bx * NTHREADS + tid, gthreads = G * NTHREADS;
    for (int it = gtid; it < 3072; it += gthreads) {
        if (it < 2048) { const int pos = it >> 5, i = it & 31; const float fr = exp2f(-(float)(2 * i) * (13.287712379549449f / 64.0f)); const float ang = (float)pos * fr;
            const float c = cosf(ang), s = sinf(ang);
            float* t1 = (float*)(ws + WS_TABR) + 2 * (pos * 32 + i); t1[0] = c; t1[1] = s;
            float* t2 = (float*)(ws + WS_TABRT) + 2 * (i * 64 + pos); t2[0] = c; t2[1] = s; }
        else { const int j = it - 2048, pos = j >> 4, i = j & 15; const float fr = exp2f(-(float)(2 * i) * (13.287712379549449f / 32.0f)); const float ang = (float)pos * fr;
            float* t1 = (float*)(ws + WS_TABD) + 2 * (pos * 16 + i); t1[0] = cosf(ang); t1[1] = sinf(ang); }
    }
    for (int i = 0; i < 2; ++i) {
        conv_w((bf16_t*)(ws + WS_WTE) + (size_t)i * 3072 * 1024, A.in[8] + (size_t)i * 1024 * 3072, 3072, 1024, 3072, 0, gtid, gthreads);
        conv_w((bf16_t*)(ws + WS_WTO) + (size_t)i * 4096 * 1024, A.in[13] + (size_t)i * 1024 * 4096, 4096, 1024, 4096, 1, gtid, gthreads);
        conv_w((bf16_t*)(ws + WS_WOT) + (size_t)(2 * i) * 1024 * 1024, A.in[9] + (size_t)i * 1024 * 1024, 1024, 1024, 1024, 2, gtid, gthreads);
        conv_w((bf16_t*)(ws + WS_WOT) + (size_t)(2 * i + 1) * 1024 * 1024, A.in[14] + (size_t)i * 1024 * 1024, 1024, 1024, 1024, 2, gtid, gthreads);
    }
    for (int m = 0; m < 8; ++m) conv_w((bf16_t*)(ws + WS_PWT) + m * 16384, A.in[11] + m * 16384, 128, 128, 128, 2, gtid, gthreads);
}

__device__ __forceinline__ void ew_phase(const Args& A, int l) {
    const int tid = threadIdx.x, lane = tid & 63, wave = tid >> 6;
    unsigned char* ws = A.ws;
    const float* MOD = (const float*)(ws + WS_MOD); const bf16_t* Y = (const bf16_t*)(ws + WS_P); bf16_t* H = (bf16_t*)(ws + WS_H); float* XC = (float*)(ws + WS_XC);
    const int nw = gridDim.x * 8;
    constexpr int NR = 4;
    for (int Ra = (blockIdx.x * 8 + wave) * NR; Ra < NTOK; Ra += NR * nw) {
        int Rr[NR]; bool act[NR]; const float* xin[NR]; float* xout[NR]; int vv[NR];
#pragma unroll
        for (int q = 0; q < NR; ++q) Rr[q] = Ra + q;
#pragma unroll
        for (int q = 0; q < NR; ++q) {
            const int R = Rr[q] < NTOK ? Rr[q] : Ra; const int b = R / SROW, s = R - b * SROW; const bool isctx = s < CTXL;
            act[q] = (Rr[q] < NTOK) && !(l == 4 && isctx); Rr[q] = R; vv[q] = isctx ? 32 : b;
            if (isctx) { const size_t o = ((size_t)b * CTXL + s) * D; xout[q] = XC + o; xin[q] = (l <= 1) ? A.in[2] + o : xout[q]; }
            else { const size_t o = ((size_t)b * SEQ + (s - CTXL)) * D; xout[q] = A.out + o; xin[q] = (l <= 1) ? A.in[0] + o : xout[q]; }
        }
        f32x4 xv[NR][4]; u32x2 yr[NR][4];
#pragma unroll
        for (int q = 0; q < NR; ++q)
#pragma unroll
            for (int k = 0; k < 4; ++k) { xv[q][k] = __builtin_nontemporal_load((const f32x4*)(xin[q] + 4 * lane + 256 * k)); if (l > 0) yr[q][k] = __builtin_nontemporal_load((const u32x2*)(Y + (size_t)Rr[q] * D + 4 * lane + 256 * k)); }
#pragma unroll
        for (int q = 0; q < NR; ++q) {
            if (l > 0) {
                f32x4 yv[4]; float ss = 0.f;
#pragma unroll
                for (int k = 0; k < 4; ++k) { yv[k] = (f32x4){bflo(yr[q][k].x), bfhi(yr[q][k].x), bflo(yr[q][k].y), bfhi(yr[q][k].y)}; ss += yv[k][0] * yv[k][0] + yv[k][1] * yv[k][1] + yv[k][2] * yv[k][2] + yv[k][3] * yv[k][3]; }
                ss = wave_sum(ss); const float r = rsqrtf(ss * (1.0f / D) + EPS);
                const float* gate = MOD + (size_t)((l - 1) * 33 + vv[q]) * 3072 + 2048; const float* np = A.in[7] + (l - 1) * D;
#pragma unroll
                for (int k = 0; k < 4; ++k) { const f32x4 g = *(const f32x4*)(gate + 4 * lane + 256 * k), n = *(const f32x4*)(np + 4 * lane + 256 * k);
                    xv[q][k] += g * (yv[k] * r * n); if (act[q]) __builtin_nontemporal_store(xv[q][k], (f32x4*)(xout[q] + 4 * lane + 256 * k)); }
            }
            if (l < 4) {
                float ss = 0.f;
#pragma unroll
                for (int k = 0; k < 4; ++k) ss += xv[q][k][0] * xv[q][k][0] + xv[q][k][1] * xv[q][k][1] + xv[q][k][2] * xv[q][k][2] + xv[q][k][3] * xv[q][k][3];
                ss = wave_sum(ss); const float r = rsqrtf(ss * (1.0f / D) + EPS);
                const float* md = MOD + (size_t)(l * 33 + vv[q]) * 3072; const float* np = A.in[6] + l * D;
#pragma unroll
                for (int k = 0; k < 4; ++k) { const f32x4 sh = *(const f32x4*)(md + 4 * lane + 256 * k), sc = *(const f32x4*)(md + 1024 + 4 * lane + 256 * k), n = *(const f32x4*)(np + 4 * lane + 256 * k);
                    const f32x4 h = xv[q][k] * r * n * (sc + 1.0f) + sh;
                    u32x2 w; w.x = cvt_pk_bf16(h[0], h[1]); w.y = cvt_pk_bf16(h[2], h[3]);
                    if (act[q]) *(u32x2*)(H + (size_t)Rr[q] * D + 4 * lane + 256 * k) = w; }
            }
        }
    }
}

constexpr int RP = 288;
__device__ __forceinline__ bf16x8 ld_frag16(LAS const unsigned char* p) { return *(LAS const bf16x8*)p; }
__device__ __forceinline__ bf16x8 ld_frag8x2(LAS const unsigned char* p0, LAS const unsigned char* p1) {
    const u32x2 a = *(LAS const u32x2*)p0, b = *(LAS const u32x2*)p1; u32x4 w; w.x = a.x; w.y = a.y; w.z = b.x; w.w = b.y; return __builtin_bit_cast(bf16x8, w); }

__device__ __forceinline__ void stage128(LAS unsigned char* dst, const bf16_t* src, size_t gp, int tid) {
    u32x4 r[4];
#pragma unroll
    for (int k = 0; k < 4; ++k) { const int q = tid + NTHREADS * k, row = q >> 4, cc = q & 15; r[k] = *(const u32x4*)(src + (size_t)row * gp + cc * 8); }
#pragma unroll
    for (int k = 0; k < 4; ++k) { const int q = tid + NTHREADS * k, row = q >> 4, cc = q & 15; *(LAS u32x4*)(dst + row * RP + cc * 16) = r[k]; }
}

__device__ __forceinline__ void retention_unit(const Args& A, LAS unsigned char* lds, int unit, int li  ) {
    const int tid = threadIdx.x, lane = tid & 63, w = __builtin_amdgcn_readfirstlane(tid >> 6), fr = lane & 15, fq = lane >> 4;
    const int b = unit >> 2, h = unit & 3;
    unsigned char* ws = A.ws;
    const bf16_t* Pn = (const bf16_t*)(ws + WS_P); float* OF = (float*)(ws + WS_OF); bf16_t* A2 = (bf16_t*)(ws + WS_H);
    LAS unsigned char* Ks = lds; LAS unsigned char* Vs = lds + 128 * RP; LAS unsigned char* Ss = lds + 2 * 128 * RP;
    const int trq = 4 * fq + (fr >> 2), trp = 8 * (fr & 3);
    LAS float* KD = (LAS float*)(lds + 3 * 128 * RP); LAS float* DT = KD + 128;
    { const float l2f_ = -__expf(A.in[10][(li * 2 + 0) * 4 + h]) * 1.4426950408889634f, l2b_ = -__expf(A.in[10][(li * 2 + 1) * 4 + h]) * 1.4426950408889634f;
      __syncthreads();
      for (int e = tid; e < 4 * 264; e += NTHREADS) { const int a = e / 264, m = e - a * 264 + a, dl = 127 - m;
          DT[e] = (dl >= 0) ? exp2f(l2f_ * (float)dl) : exp2f(-l2b_ * (float)dl); } }

    const int iloc = 16 * w + fr;
    LAS const float* dtp = DT + ((127 - iloc) & 3) * 264 + ((127 - iloc) & ~3) + 4 * fq;
#pragma unroll 1
    for (int dir = 0; dir < 2; ++dir) {
        const float l2 = -__expf(A.in[10][(li * 2 + dir) * 4 + h]) * 1.4426950408889634f;
        const float cdec = exp2f(l2 * 128.0f);
        const float qd = exp2f(l2 * (dir == 0 ? (float)(iloc + 1) : (float)(128 - iloc)));
        f32x4 accS[8];
#pragma unroll
        for (int dt = 0; dt < 8; ++dt) accS[dt] = (f32x4){0.f, 0.f, 0.f, 0.f};
        __syncthreads();
        if (tid < 128) KD[tid] = exp2f(l2 * (dir == 0 ? (float)(127 - tid) : (float)tid));
        for (int q = tid; q < 128 * 16; q += NTHREADS) *(LAS u32x4*)(Ss + (q >> 4) * RP + (q & 15) * 16) = (u32x4){0u, 0u, 0u, 0u};
#pragma unroll 1
        for (int step = 0; step < 18; ++step) {
            const int c = (dir == 0) ? step : (step < 2 ? 1 - step : 19 - step);
            const size_t R0 = (size_t)b * SROW + c * 128;
            LAS const float* dtpv = dtp; LAS const float* kdv = KD + 4 * fq; asm volatile("" : "+v"(dtpv), "+v"(kdv));
            bf16x8 Qf[4];
            { u32x4 r0[4], r1[4];
              const bf16_t* s0 = Pn + R0 * 3072 + 2048 + h * 128;
#pragma unroll
              for (int k = 0; k < 4; ++k) { const int q = tid + NTHREADS * k, row = q >> 4, cc = q & 15; r0[k] = *(const u32x4*)(s0 + (size_t)row * 3072 + cc * 8); r1[k] = *(const u32x4*)(s0 + 512 + (size_t)row * 3072 + cc * 8); }
              const bf16_t* qp = Pn + (R0 + iloc) * 3072 + h * 128 + 8 * fq;
#pragma unroll
              for (int ds = 0; ds < 4; ++ds) Qf[ds] = *(const bf16x8*)(qp + 32 * ds);
#pragma unroll
              for (int k = 0; k < 4; ++k) { const int q = tid + NTHREADS * k, row = q >> 4, cc = q & 15; *(LAS u32x4*)(Ks + row * RP + cc * 16) = r0[k]; *(LAS u32x4*)(Vs + row * RP + cc * 16) = r1[k]; } }
            __syncthreads();
            f32x4 accO[8];
#pragma unroll
            for (int hb = 0; hb < 4; ++hb) { bf16x8 fa[8];
#pragma unroll
                for (int q = 0; q < 8; ++q) fa[q] = ld_frag16(Ss + (16 * (2 * hb + (q >> 2)) + fr) * RP + (32 * (q & 3) + 8 * fq) * 2);
                __builtin_amdgcn_sched_barrier(0);
#pragma unroll
                for (int v2 = 0; v2 < 2; ++v2) { f32x4 a = {0.f, 0.f, 0.f, 0.f};
#pragma unroll
                    for (int ds = 0; ds < 4; ++ds) a = mfma16(fa[v2 * 4 + ds], Qf[ds], a);
                    accO[2 * hb + v2] = a * qd; }
                __builtin_amdgcn_sched_barrier(0); }
            if (dir == 1) {
#pragma unroll
            for (int jp = 0; jp < 4; ++jp) { float pv[8];
                bf16x8 fk[8];
#pragma unroll
                for (int q = 0; q < 8; ++q) fk[q] = ld_frag16(Ks + (16 * (2 * jp + (q >> 2)) + fr) * RP + (32 * (q & 3) + 8 * fq) * 2);
                __builtin_amdgcn_sched_barrier(0);
#pragma unroll
                for (int hf = 0; hf < 2; ++hf) { const int jt = 2 * jp + hf; f32x4 sc = {0.f, 0.f, 0.f, 0.f};
#pragma unroll
                    for (int ds = 0; ds < 4; ++ds) sc = mfma16(fk[hf * 4 + ds], Qf[ds], sc);
                    { const f32x4 dw = *(LAS const f32x4*)(dtpv + 16 * jt);
#pragma unroll
                      for (int r = 0; r < 4; ++r) pv[4 * hf + r] = sc[r] * dw[r]; } }
                u32x4 wv; wv.x = cvt_pk_bf16(pv[0], pv[1]); wv.y = cvt_pk_bf16(pv[2], pv[3]); wv.z = cvt_pk_bf16(pv[4], pv[5]); wv.w = cvt_pk_bf16(pv[6], pv[7]);
                const bf16x8 PBj = __builtin_bit_cast(bf16x8, wv);
                bf16x8 fv[8];
#pragma unroll
                for (int vt = 0; vt < 8; ++vt) { LAS const unsigned char* vp = Vs + (32 * jp + trq) * RP + vt * 32 + trp; fv[vt] = ld_tr8(vp, vp + 16 * RP); }
                __builtin_amdgcn_sched_barrier(0);
#pragma unroll
                for (int vt = 0; vt < 8; ++vt) accO[vt] = mfma16(fv[vt], PBj, accO[vt]);
                __builtin_amdgcn_sched_barrier(0); }
            }
            { float* ofp = OF + (R0 + iloc) * 512 + h * 128 + 4 * fq;
              if (dir == 0) {
#pragma unroll
                  for (int vt = 0; vt < 8; ++vt) *(f32x4*)(ofp + 16 * vt) = accO[vt];
              } else {
                  float s1 = 0.f;
#pragma unroll
                  for (int vt = 0; vt < 8; ++vt) { accO[vt] += *(const f32x4*)(ofp + 16 * vt); s1 += (accO[vt][0] + accO[vt][1]) + (accO[vt][2] + accO[vt][3]); }
                  s1 = xrow16_sum(s1);
                  const float mu = s1 * (1.0f / 128.0f); float s2 = 0.f;
#pragma unroll
                  for (int vt = 0; vt < 8; ++vt) { const f32x4 d = accO[vt] - mu; s2 += (d[0] * d[0] + d[1] * d[1]) + (d[2] * d[2] + d[3] * d[3]); }
                  s2 = xrow16_sum(s2);
                  const float rs = rsqrtf(s2 * (1.0f / 128.0f) + EPS);
                  const bf16_t* gp = Pn + (R0 + iloc) * 3072 + 512 + h * 128 + 4 * fq; bf16_t* op = A2 + (R0 + iloc) * 1024 + h * 128 + 4 * fq;
#pragma unroll
                  for (int vt = 0; vt < 8; ++vt) { const u32x2 g = *(const u32x2*)(gp + 16 * vt);
                      const float o0 = (accO[vt][0] - mu) * rs * silu_f(bflo(g.x)), o1 = (accO[vt][1] - mu) * rs * silu_f(bfhi(g.x));
                      const float o2 = (accO[vt][2] - mu) * rs * silu_f(bflo(g.y)), o3 = (accO[vt][3] - mu) * rs * silu_f(bfhi(g.y));
                      u32x2 wv; wv.x = cvt_pk_bf16(o0, o1); wv.y = cvt_pk_bf16(o2, o3); *(u32x2*)(op + 16 * vt) = wv; }
              } }
            bf16x8 Vd[4];
#pragma unroll
            for (int js = 0; js < 4; ++js) { LAS const unsigned char* vp = Vs + (32 * js + trq) * RP + w * 32 + trp; const u32x4 raw = __builtin_bit_cast(u32x4, ld_tr8(vp, vp + 16 * RP)); float kd[8];
                { const f32x4 k0 = *(LAS const f32x4*)(kdv + 32 * js), k1 = *(LAS const f32x4*)(kdv + 32 * js + 16); kd[0] = k0[0]; kd[1] = k0[1]; kd[2] = k0[2]; kd[3] = k0[3]; kd[4] = k1[0]; kd[5] = k1[1]; kd[6] = k1[2]; kd[7] = k1[3]; }
                u32x4 wv; wv.x = cvt_pk_bf16(bflo(raw.x) * kd[0], bfhi(raw.x) * kd[1]); wv.y = cvt_pk_bf16(bflo(raw.y) * kd[2], bfhi(raw.y) * kd[3]);
                wv.z = cvt_pk_bf16(bflo(raw.z) * kd[4], bfhi(raw.z) * kd[5]); wv.w = cvt_pk_bf16(bflo(raw.w) * kd[6], bfhi(raw.w) * kd[7]);
                Vd[js] = __builtin_bit_cast(bf16x8, wv); }
#pragma unroll
            for (int hb = 0; hb < 4; ++hb) { bf16x8 fk[8];
#pragma unroll
                for (int q = 0; q < 8; ++q) { LAS const unsigned char* kp = Ks + (32 * (q & 3) + trq) * RP + (2 * hb + (q >> 2)) * 32 + trp; fk[q] = ld_tr8(kp, kp + 16 * RP); }
                __builtin_amdgcn_sched_barrier(0);
#pragma unroll
                for (int d2 = 0; d2 < 2; ++d2) { f32x4 a = accS[2 * hb + d2] * cdec;
#pragma unroll
                    for (int js = 0; js < 4; ++js) a = mfma16(fk[d2 * 4 + js], Vd[js], a);
                    accS[2 * hb + d2] = a; }
                __builtin_amdgcn_sched_barrier(0); }
            __syncthreads();
#pragma unroll
            for (int dt = 0; dt < 8; ++dt) { u32x2 wv; wv.x = cvt_pk_bf16(accS[dt][0], accS[dt][1]); wv.y = cvt_pk_bf16(accS[dt][2], accS[dt][3]);
                *(LAS u32x2*)(Ss + (16 * w + fr) * RP + (16 * dt + 4 * fq) * 2) = wv; }
        }
    }
    __syncthreads();
}

constexpr int POOL_PIN = 0, POOL_DSM = 144 * RP, POOL_PW = POOL_DSM + 128 * RP;
template <int GI> __device__ __forceinline__ void pool_body(const Args& A, LAS unsigned char* lds, int seg, int li) {
    constexpr int win = 2 << GI, hw = win >> 1, g = GI;
    const int tid = threadIdx.x, lane = tid & 63, w = tid >> 6, fr = lane & 15, fq = lane >> 4;
    unsigned char* ws = A.ws;
    const bf16_t* Pn = (const bf16_t*)(ws + WS_P); bf16_t* A2 = (bf16_t*)(ws + WS_H);
    const size_t R0 = (size_t)seg * 128; const int s0 = (int)(R0 % SROW); const bool isctx = s0 < CTXL;
    const int TT = isctx ? CTXL : SEQ, t0 = isctx ? s0 : s0 - CTXL; const size_t Rseq = R0 - t0;
    LAS unsigned char* pin = lds + POOL_PIN; LAS unsigned char* dsm = lds + POOL_DSM; LAS const unsigned char* PWs = lds + POOL_PW;
    u32x4 rr[5];
#pragma unroll
    for (int k = 0; k < 5; ++k) { const int q = tid + NTHREADS * k, row = q >> 4, cc = q & 15, t = t0 - 8 + row; const bool ok = (q < 144 * 16) && t >= 0 && t < TT;
        rr[k] = (u32x4){0u, 0u, 0u, 0u}; if (ok) rr[k] = *(const u32x4*)(Pn + (Rseq + t) * 3072 + 1024 + g * 128 + cc * 8); }
    const size_t R = R0 + 16 * w + fr;
    const bf16_t* gp = Pn + R * 3072 + 1536 + g * 128 + 4 * fq;
    u32x2 gg[8];
#pragma unroll
    for (int dt = 0; dt < 8; ++dt) gg[dt] = *(const u32x2*)(gp + 16 * dt);
    __syncthreads();
#pragma unroll
    for (int k = 0; k < 5; ++k) { const int q = tid + NTHREADS * k; if (q < 144 * 16) *(LAS u32x4*)(pin + (q >> 4) * RP + (q & 15) * 16) = rr[k]; }
    __syncthreads();
#pragma unroll
    for (int k = 0; k < 4; ++k) { const int q = tid + NTHREADS * k, tl = q >> 4, cc = q & 15, t = t0 + tl;
        const int lo = max(t - hw, 0), hi = min(t + hw - 1, TT - 1);
        float sm[8];
#pragma unroll
        for (int e = 0; e < 8; ++e) sm[e] = 0.f;
#pragma unroll
        for (int ww = 0; ww < win; ++ww) { const u32x4 r = *(LAS const u32x4*)(pin + (tl + 8 - hw + ww) * RP + cc * 16);
            sm[0] += bflo(r.x); sm[1] += bfhi(r.x); sm[2] += bflo(r.y); sm[3] += bfhi(r.y); sm[4] += bflo(r.z); sm[5] += bfhi(r.z); sm[6] += bflo(r.w); sm[7] += bfhi(r.w); }
        const float inv = 1.0f / (float)(hi - lo + 1);
        const u32x4 c = *(LAS const u32x4*)(pin + (tl + 8) * RP + cc * 16);
        u32x4 wv; wv.x = cvt_pk_bf16(sm[0] * inv - bflo(c.x), sm[1] * inv - bfhi(c.x)); wv.y = cvt_pk_bf16(sm[2] * inv - bflo(c.y), sm[3] * inv - bfhi(c.y));
        wv.z = cvt_pk_bf16(sm[4] * inv - bflo(c.z), sm[5] * inv - bfhi(c.z)); wv.w = cvt_pk_bf16(sm[6] * inv - bflo(c.w), sm[7] * inv - bfhi(c.w));
        *(LAS u32x4*)(dsm + tl * RP + cc * 16) = wv; }
    __syncthreads();
    bf16x8 Bf[4];
#pragma unroll
    for (int cs = 0; cs < 4; ++cs) Bf[cs] = ld_frag16(dsm + (16 * w + fr) * RP + (32 * cs + 8 * fq) * 2);
    const float* psc = A.in[12] + li * 512 + g * 128 + 4 * fq;
    bf16_t* op = A2 + R * 1024 + 512 + g * 128 + 4 * fq;
#pragma unroll
    for (int hb = 0; hb < 4; ++hb) { bf16x8 fa[8];
#pragma unroll
        for (int q = 0; q < 8; ++q) fa[q] = ld_frag16(PWs + (16 * (2 * hb + (q >> 2)) + fr) * RP + (32 * (q & 3) + 8 * fq) * 2);
        __builtin_amdgcn_sched_barrier(0);
#pragma unroll
        for (int d2 = 0; d2 < 2; ++d2) { const int dt = 2 * hb + d2; f32x4 a = {0.f, 0.f, 0.f, 0.f};
#pragma unroll
            for (int cs = 0; cs < 4; ++cs) a = mfma16(fa[d2 * 4 + cs], Bf[cs], a);
            const f32x4 sc = *(const f32x4*)(psc + 16 * dt);
            u32x2 wv; wv.x = cvt_pk_bf16(a[0] * sc[0] * silu_f(bflo(gg[dt].x)), a[1] * sc[1] * silu_f(bfhi(gg[dt].x))); wv.y = cvt_pk_bf16(a[2] * sc[2] * silu_f(bflo(gg[dt].y)), a[3] * sc[3] * silu_f(bfhi(gg[dt].y)));
            *(u32x2*)(op + 16 * dt) = wv; }
        __builtin_amdgcn_sched_barrier(0); }
}
__device__ __forceinline__ void pool_stage_w(const Args& A, LAS unsigned char* lds, int g, int li) {
    const bf16_t* PW = (const bf16_t*)(A.ws + WS_PWT) + (size_t)(li * 4 + g) * 16384;
    __syncthreads();
    for (int q = threadIdx.x; q < 128 * 16; q += NTHREADS) *(LAS u32x4*)(lds + POOL_PW + (q >> 4) * RP + (q & 15) * 16) = *(const u32x4*)(PW + q * 8);
    __syncthreads();
}
__device__ __forceinline__ void pool_unit(const Args& A, LAS unsigned char* lds, int unit, int li, int& cur_g) {
    const int seg = unit >> 2, g = unit & 3;
    if (g != cur_g) { pool_stage_w(A, lds, g, li); cur_g = g; }
    switch (g) { case 0: pool_body<0>(A, lds, seg, li); break; case 1: pool_body<1>(A, lds, seg, li); break; case 2: pool_body<2>(A, lds, seg, li); break; default: pool_body<3>(A, lds, seg, li); break; }
}

#ifdef NO_RET
#define DIS_RET(...)
#else
#define DIS_RET(...) __VA_ARGS__
#endif
#ifdef NO_POOL
#define DIS_POOL(...)
#else
#define DIS_POOL(...) __VA_ARGS__
#endif
__device__ __forceinline__ void even_mixer_phase(const Args& A, LAS unsigned char* lds, int li, int part = 0) {
    const int G = gridDim.x, bx = blockIdx.x;
    const int nret = 128; int cur_g = -1;
    if (G > nret) {
        if (bx < nret) { if (part != 2) { DIS_RET(retention_unit(A, lds, bx, li);) } }
        else if (part != 1) for (int u = bx - nret; u < 576 * 4; u += G - nret) { DIS_POOL(pool_unit(A, lds, u, li, cur_g);) }
    } else {
        if (part != 2) for (int u = bx; u < nret; u += G) { DIS_RET(retention_unit(A, lds, u, li);) }
        if (part != 1) for (int u = bx; u < 576 * 4; u += G) { DIS_POOL(pool_unit(A, lds, u, li, cur_g);) }
    }
}

constexpr int KT_BYTES = 64 * 256, VT_BYTES = 64 * 256, AV_OFF = 2 * KT_BYTES;

__device__ __forceinline__ void attn_unit(const Args& A, LAS unsigned char* lds, int unit, int l, float lam, float lam_init) {
    const int tid = threadIdx.x, lane = tid & 63, w = __builtin_amdgcn_readfirstlane(tid >> 6), fr = lane & 15, fq = lane >> 4;
    const int li = l >> 1;
    int b, h, qrow0, nkt;
    if (unit < 4096) { const int bh = unit >> 4, qb = unit & 15; b = bh >> 3; h = bh & 7; qrow0 = CTXL + qb * 128; nkt = 36; }
    else { const int u2 = unit - 4096, bh = u2 >> 1, qb = u2 & 1; b = bh >> 3; h = bh & 7; qrow0 = qb * 128; nkt = 4; }
    unsigned char* ws = A.ws;
    const bf16_t* Pn = (const bf16_t*)(ws + WS_P); bf16_t* A2 = (bf16_t*)(ws + WS_H);
    const size_t Rb = (size_t)b * SROW; const size_t Rq = Rb + qrow0 + 16 * w + fr;
    const float cs = 0.125f * 1.4426950408889634f;
    bf16x8 Qf[2][2];
#pragma unroll
    for (int mp = 0; mp < 2; ++mp)
#pragma unroll
        for (int ds = 0; ds < 2; ++ds) { const u32x4 raw = *(const u32x4*)(Pn + Rq * 2048 + h * 128 + mp * 64 + 32 * ds + 8 * fq); u32x4 wq;
            wq.x = cvt_pk_bf16(bflo(raw.x) * cs, bfhi(raw.x) * cs); wq.y = cvt_pk_bf16(bflo(raw.y) * cs, bfhi(raw.y) * cs); wq.z = cvt_pk_bf16(bflo(raw.z) * cs, bfhi(raw.z) * cs); wq.w = cvt_pk_bf16(bflo(raw.w) * cs, bfhi(raw.w) * cs);
            Qf[mp][ds] = __builtin_bit_cast(bf16x8, wq); }
    const bf16_t* kbase = (const bf16_t*)(ws + WS_OF) + (size_t)(b * 8 + h) * SROW * 128; const bf16_t* vbase = (const bf16_t*)(ws + WS_T) + (size_t)(b * 8 + h) * SROW * 128;
    int ksrc[2], vsrc[2];
#pragma unroll
    for (int i = 0; i < 2; ++i) { const int row = (i * 8 + w) * 4 + (lane >> 4), p = lane & 15; ksrc[i] = row * 128 + (p ^ (row & 15)) * 8; vsrc[i] = row * 128 + (p ^ (2 * (row & 7))) * 8; }
#define ATT_DMA(t, kbuf, vbuf) do { const size_t to_ = (size_t)(t) * 8192; \
        _Pragma("unroll") for (int i_ = 0; i_ < 2; ++i_) { \
            __builtin_amdgcn_global_load_lds((const unsigned*)(kbase + to_ + ksrc[i_]), (LAS unsigned*)(lds + (kbuf) * KT_BYTES + (i_ * 8 + w) * 1024), 16, 0, 0); \
            __builtin_amdgcn_global_load_lds((const unsigned*)(vbase + to_ + vsrc[i_]), (LAS unsigned*)(lds + AV_OFF + (vbuf) * VT_BYTES + (i_ * 8 + w) * 1024), 16, 0, 0); } } while (0)
    int koff[2][2];
#pragma unroll
    for (int mp = 0; mp < 2; ++mp)
#pragma unroll
        for (int ds = 0; ds < 2; ++ds) koff[mp][ds] = fr * 256 + (((mp * 8 + ds * 4 + fq) ^ fr) * 16);
    const int gg32 = (4 * (fq & 1) + (fr >> 2)) * 32;
    const int vlane = (4 * fq + (fr >> 2)) * 256 + ((fr & 3) >> 1) * 16 + (fr & 1) * 8;
    f32x4 acc[2][8];
#pragma unroll
    for (int mp = 0; mp < 2; ++mp)
#pragma unroll
        for (int vt = 0; vt < 8; ++vt) acc[mp][vt] = (f32x4){0.f, 0.f, 0.f, 0.f};
    float lsum[2] = {0.f, 0.f}; f32x4 negm[2] = {{0.f, 0.f, 0.f, 0.f}, {0.f, 0.f, 0.f, 0.f}};
#define ATT_TILE(KOFF, VOFF, first) do { LAS const unsigned char* kb = lds + (KOFF); LAS const unsigned char* vb_ = lds + (VOFF) + vlane; \
        f32x4 s[2][4]; \
        _Pragma("unroll") for (int mp = 0; mp < 2; ++mp) { bf16x8 kf[8]; \
            _Pragma("unroll") for (int q = 0; q < 8; ++q) kf[q] = ld_frag16(kb + (q >> 1) * 4096 + koff[mp][q & 1]); \
            __builtin_amdgcn_sched_barrier(0); \
            _Pragma("unroll") for (int jt = 0; jt < 4; ++jt) s[mp][jt] = mfma16(kf[jt * 2 + 1], Qf[mp][1], mfma16(kf[jt * 2], Qf[mp][0], negm[mp])); \
            __builtin_amdgcn_sched_barrier(0); } \
        bf16x8 PB[2][2]; float ps[2]; \
        _Pragma("unroll") for (int mp = 0; mp < 2; ++mp) { float a_ = 0.f; f32x4 p[4]; \
            _Pragma("unroll") for (int jt = 0; jt < 4; ++jt) _Pragma("unroll") for (int r = 0; r < 4; ++r) { p[jt][r] = __builtin_amdgcn_exp2f(s[mp][jt][r]); a_ += p[jt][r]; } \
            ps[mp] = a_; \
            _Pragma("unroll") for (int jp = 0; jp < 2; ++jp) { u32x4 wv; wv.x = cvt_pk_bf16(p[2 * jp][0], p[2 * jp][1]); wv.y = cvt_pk_bf16(p[2 * jp][2], p[2 * jp][3]); \
                wv.z = cvt_pk_bf16(p[2 * jp + 1][0], p[2 * jp + 1][1]); wv.w = cvt_pk_bf16(p[2 * jp + 1][2], p[2 * jp + 1][3]); PB[mp][jp] = __builtin_bit_cast(bf16x8, wv); } } \
        if ((first) || __any(!(fmaxf(ps[0], ps[1]) < 512.0f))) { \
            _Pragma("unroll") for (int mp = 0; mp < 2; ++mp) { \
                float m_ = fmaxf(fmaxf(s[mp][0][0], s[mp][0][1]), fmaxf(s[mp][0][2], s[mp][0][3])); \
                _Pragma("unroll") for (int jt = 1; jt < 4; ++jt) m_ = fmaxf(fmaxf(m_, s[mp][jt][0]), fmaxf(fmaxf(s[mp][jt][1], s[mp][jt][2]), s[mp][jt][3])); \
                m_ = xrow16_max(m_); \
                const float delta = (first) ? m_ : fmaxf(m_, 0.f); \
                const float alpha = (first) ? 0.f : __builtin_amdgcn_exp2f(-delta); \
                negm[mp] -= delta; lsum[mp] *= alpha; \
                _Pragma("unroll") for (int vt = 0; vt < 8; ++vt) acc[mp][vt] *= alpha; \
                float a_ = 0.f; f32x4 p[4]; \
                _Pragma("unroll") for (int jt = 0; jt < 4; ++jt) _Pragma("unroll") for (int r = 0; r < 4; ++r) { p[jt][r] = __builtin_amdgcn_exp2f(s[mp][jt][r] - delta); a_ += p[jt][r]; } \
                ps[mp] = a_; \
                _Pragma("unroll") for (int jp = 0; jp < 2; ++jp) { u32x4 wv; wv.x = cvt_pk_bf16(p[2 * jp][0], p[2 * jp][1]); wv.y = cvt_pk_bf16(p[2 * jp][2], p[2 * jp][3]); \
                    wv.z = cvt_pk_bf16(p[2 * jp + 1][0], p[2 * jp + 1][1]); wv.w = cvt_pk_bf16(p[2 * jp + 1][2], p[2 * jp + 1][3]); PB[mp][jp] = __builtin_bit_cast(bf16x8, wv); } } \
        } \
        lsum[0] += ps[0]; lsum[1] += ps[1]; \
        _Pragma("unroll") for (int hb_ = 0; hb_ < 2; ++hb_) { bf16x8 vf_[8]; \
            _Pragma("unroll") for (int q_ = 0; q_ < 8; ++q_) { LAS const unsigned char* vp = vb_ + (q_ & 1) * (32 * 256) + (((hb_ * 4 + (q_ >> 1)) * 32) ^ gg32); vf_[q_] = ld_tr8(vp, vp + 16 * 256); } \
            __builtin_amdgcn_sched_barrier(0); \
            _Pragma("unroll") for (int q_ = 0; q_ < 8; ++q_) { acc[0][hb_ * 4 + (q_ >> 1)] = mfma16(vf_[q_], PB[0][q_ & 1], acc[0][hb_ * 4 + (q_ >> 1)]); acc[1][hb_ * 4 + (q_ >> 1)] = mfma16(vf_[q_], PB[1][q_ & 1], acc[1][hb_ * 4 + (q_ >> 1)]); } \
            __builtin_amdgcn_sched_barrier(0); } } while (0)
#define ATT_DMA2(t, KOFF, VOFF) do { const size_t to_ = (size_t)(t) * 8192; \
        _Pragma("unroll") for (int i_ = 0; i_ < 2; ++i_) { \
            __builtin_amdgcn_global_load_lds((const unsigned*)(kbase + to_ + ksrc[i_]), (LAS unsigned*)(lds + (KOFF) + (i_ * 8 + w) * 1024), 16, 0, 0); \
            __builtin_amdgcn_global_load_lds((const unsigned*)(vbase + to_ + vsrc[i_]), (LAS unsigned*)(lds + (VOFF) + (i_ * 8 + w) * 1024), 16, 0, 0); } } while (0)
    __syncthreads();
    ATT_DMA2(0, 0, 16384);
    asm volatile("s_waitcnt vmcnt(0)" ::: "memory");
    __syncthreads();
    const int nit = nkt >> 1;
    for (int it = 0; it < nit; ++it) {
        ATT_DMA2(2 * it + 1, 32768, 49152);
        ATT_TILE(0, 16384, it == 0);
        asm volatile("s_waitcnt vmcnt(0)" ::: "memory");
        __syncthreads();
        if (it + 1 < nit) ATT_DMA2(2 * it + 2, 0, 16384);
        ATT_TILE(32768, 49152, false);
        asm volatile("s_waitcnt vmcnt(0)" ::: "memory");
        __syncthreads();
    }
#undef ATT_TILE
#undef ATT_DMA2
#undef ATT_DMA
#undef ATT_PV
    float l0 = lsum[0], l1 = lsum[1];
    l0 = xrow16_sum(l0); l1 = xrow16_sum(l1);
    const float i0 = 1.0f / l0, i1 = lam / l1;
    float ss = 0.f;
#pragma unroll
    for (int vt = 0; vt < 8; ++vt) { acc[0][vt] = acc[0][vt] * i0 - acc[1][vt] * i1; ss += (acc[0][vt][0] * acc[0][vt][0] + acc[0][vt][1] * acc[0][vt][1]) + (acc[0][vt][2] * acc[0][vt][2] + acc[0][vt][3] * acc[0][vt][3]); }
    ss = xrow16_sum(ss);
    const float rs = rsqrtf(ss * (1.0f / 128.0f) + EPS) * (1.0f - lam_init);
    const float* sub = A.in[16] + li * 128 + 4 * fq; const bf16_t* gp = Pn + Rq * 2048 + 1024 + h * 128 + 4 * fq; bf16_t* op = A2 + Rq * 1024 + h * 128 + 4 * fq;
#pragma unroll
    for (int vt = 0; vt < 8; ++vt) { const f32x4 sb = *(const f32x4*)(sub + 16 * vt); const u32x2 g = *(const u32x2*)(gp + 16 * vt);
        u32x2 wv; wv.x = cvt_pk_bf16(acc[0][vt][0] * rs * sb[0] * silu_f(bflo(g.x)), acc[0][vt][1] * rs * sb[1] * silu_f(bfhi(g.x)));
        wv.y = cvt_pk_bf16(acc[0][vt][2] * rs * sb[2] * silu_f(bflo(g.y)), acc[0][vt][3] * rs * sb[3] * silu_f(bfhi(g.y)));
        *(u32x2*)(op + 16 * vt) = wv; }
}

__device__ __forceinline__ void odd_mixer_phase(const Args& A, LAS unsigned char* lds, int l) {
    const int G = gridDim.x, bx = blockIdx.x, li = l >> 1;
    const float* lp = A.in[15] + li * 256; float d0 = 0.f, d1 = 0.f;
    for (int e = 0; e < 64; ++e) { d0 += lp[e] * lp[64 + e]; d1 += lp[128 + e] * lp[192 + e]; }
    const float lam_init = 0.8f - 0.6f * expf(-0.3f * (float)l);
    const float lam = expf(d0) - expf(d1) + lam_init;
    const int vcu = (G % 8 == 0) ? (bx % 8) * (G / 8) + bx / 8 : bx;
    const int nunits = (l == 3) ? 4096 : 4608;
    for (int u = vcu; u < nunits; u += G) attn_unit(A, lds, u, l, lam, lam_init);
}


#define XB_TMO      128
#define XB_XCNT(j)  (256  + 64 * (j))
#define XB_XSUB(j)  (1280 + 64 * (j))
#define XB_XGEN(j)  (2304 + 64 * (j))
#define XB_TOP      3328
#define XB_TOPGEN   3392
#define XCD_BAR_WORDS 3456
#define XB_SPIN_CAP (1u << 18)

__device__ __forceinline__ unsigned xb_ld(unsigned* p)              { return __hip_atomic_load(p, __ATOMIC_RELAXED, __HIP_MEMORY_SCOPE_AGENT); }
__device__ __forceinline__ unsigned xb_add(unsigned* p, unsigned v) { return __hip_atomic_fetch_add(p, v, __ATOMIC_RELAXED, __HIP_MEMORY_SCOPE_AGENT); }
__device__ __forceinline__ unsigned xb_xcc_id() { return (unsigned)__builtin_amdgcn_s_getreg((3 << 11) | 20) & 0xFu; }
#define XB_SPIN(cond, bar) do { unsigned _sp = 0; while (cond) { __builtin_amdgcn_s_sleep(1); \
    if ((++_sp & 255u) == 0u) { if (xb_ld(&(bar)[XB_TMO])) break; if (_sp > XB_SPIN_CAP) { atomicAdd(&(bar)[XB_TMO], 1u); break; } } } } while (0)

struct XcdBarrier {
    unsigned* bar; unsigned x;
    volatile LAS unsigned* st;
};

__device__ __forceinline__ XcdBarrier xcd_barrier_post(unsigned* bar, volatile LAS unsigned* st) {
    XcdBarrier b; b.bar = bar; b.x = xb_xcc_id(); b.st = st;
    if (threadIdx.x == 0) (void)xb_add(&bar[XB_XCNT(b.x)], 1u);
    return b;
}
__device__ __forceinline__ void xcd_barrier_complete(unsigned* bar, unsigned x, unsigned& nloc, unsigned& nx) {
    const unsigned G = gridDim.x * gridDim.y * gridDim.z;
    unsigned sum, cnt, mine, sp = 0u;
    for (;;) {
        sum = 0u; cnt = 0u; mine = 0u;
#pragma unroll
        for (unsigned j = 0; j < 16; ++j) { const unsigned c = xb_ld(&bar[XB_XCNT(j)]); sum += c; cnt += (c > 0u) ? 1u : 0u; mine = (j == x) ? c : mine; }
        if (sum == G) break;
        __builtin_amdgcn_s_sleep(1);
        if ((++sp & 255u) == 0u) { if (xb_ld(&bar[XB_TMO])) break; if (sp > XB_SPIN_CAP) { atomicAdd(&bar[XB_TMO], 1u); break; } }
    }
    nloc = mine > 0u ? mine : 1u; nx = cnt > 0u ? cnt : 1u;
}

__device__ __forceinline__ void xcd_barrier(const XcdBarrier& b) {
    asm volatile("s_waitcnt vmcnt(0)" ::: "memory");
    __syncthreads();
    if (threadIdx.x == 0) {
        unsigned* bar = b.bar;
        __builtin_amdgcn_s_waitcnt(0);
        unsigned nloc = b.st[0], nx = b.st[1];
        if (nloc == 0u) { xcd_barrier_complete(bar, b.x, nloc, nx); b.st[0] = nloc; b.st[1] = nx; }
        const unsigned old = xb_add(&bar[XB_XSUB(b.x)], 1u);
        const unsigned gen = old / nloc;
        if (old + 1u == (gen + 1u) * nloc) {
            __builtin_amdgcn_fence(__ATOMIC_RELEASE, "agent");
            asm volatile("s_waitcnt vmcnt(0)" ::: "memory");
            const unsigned og = xb_add(&bar[XB_TOP], 1u);
            const unsigned tg = og / nx;
            if (og + 1u == (tg + 1u) * nx) xb_add(&bar[XB_TOPGEN], 1u);
            else XB_SPIN(xb_ld(&bar[XB_TOPGEN]) == tg, bar);
            __builtin_amdgcn_fence(__ATOMIC_ACQUIRE, "agent");
            xb_add(&bar[XB_XGEN(b.x)], 1u);
            asm volatile("s_waitcnt vmcnt(0)" ::: "memory");
        } else {
            XB_SPIN(xb_ld(&bar[XB_XGEN(b.x)]) == gen, bar);
            __builtin_amdgcn_fence(__ATOMIC_ACQUIRE, "agent");
            asm volatile("s_waitcnt vmcnt(0)" ::: "memory");
        }
    }
    __syncthreads();
}


#ifdef NO_PRO
#define DIS_PRO(...)
#else
#define DIS_PRO(...) __VA_ARGS__
#endif
#ifdef NO_EW
#define DIS_EW(...)
#else
#define DIS_EW(...) __VA_ARGS__
#endif
#ifdef NO_EVEN
#define DIS_EVEN(...)
#else
#define DIS_EVEN(...) __VA_ARGS__
#endif
#ifdef NO_ODD
#define DIS_ODD(...)
#else
#define DIS_ODD(...) __VA_ARGS__
#endif
#ifdef NO_G1
#define DIS_G1(...)
#else
#define DIS_G1(...) __VA_ARGS__
#endif
#ifdef NO_G2
#define DIS_G2(...)
#else
#define DIS_G2(...) __VA_ARGS__
#endif
#ifdef NO_G3
#define DIS_G3(...)
#else
#define DIS_G3(...) __VA_ARGS__
#endif
template <bool EXTRA> struct TrimOrder : pg8::StaticOrder {
    __device__ void init2(int ncoltiles, int G_, int c_) { init(256 * 256, ncoltiles * 256, G_, c_); }
    __device__ bool next(int i, pg8::Unit& u) const {
        const long L = (long)i * G + c;
        if (L < nwg) { pg8::StaticOrder::next(i, u); u.pm = (u.pm >> 3) * 9 + (u.pm & 7) + 1; return true; }
        if (EXTRA) { const int L2 = (int)(L - nwg); if (L2 >= 256) return false; u.pm = 9 * (L2 >> 3); const int t = L2 & 7; u.pn = t < 4 ? 4 + t : 8 + t; return true; }
        return false;
    }
};
template <int PH> __device__ __forceinline__ void run_phase(const Args& A, LAS unsigned char* lds) {
    unsigned char* ws = A.ws;
    const int G = gridDim.x, bx = blockIdx.x;
    if constexpr (PH == 0) { DIS_PRO(prologue_phase(A, lds);) }
    else if constexpr (PH == 1) { DIS_EW(ew_phase(A, 0);) }
    else {
        constexpr int l = (PH - 2) >> 2, sub = (PH - 2) & 3, li = l >> 1;
        const bf16_t* H = (const bf16_t*)(ws + WS_H);
        if constexpr (sub == 0) {
            if constexpr ((l & 1) == 0) {
                const bf16_t* W = (const bf16_t*)(ws + WS_WTE) + (size_t)li * 3072 * 1024;
                pg8::Gemm g{H, W, NTOK, 3072, 1024}; pg8::StaticOrder S; S.init(NTOK, 3072, G, bx);
                EpiInNat<0> E{(bf16_t*)(ws + WS_P), 3072, (const f32x4*)(ws + WS_TABR), nullptr, nullptr};
                DIS_G1(pg8::gemm_phase<EpiInNat<0>, pg8::StaticOrder>(lds, g, S, E, nullptr);)
            } else {
                const bf16_t* W = (const bf16_t*)(ws + WS_WTO) + (size_t)li * 4096 * 1024;
                pg8::Gemm g{H, W, NTOK, 4096, 1024};
                EpiInNat<1> E{(bf16_t*)(ws + WS_P), 2048, (const f32x4*)(ws + WS_TABD), (bf16_t*)(ws + WS_OF), (bf16_t*)(ws + WS_T)};
                if constexpr (l == 3) { TrimOrder<true> S; S.init2(16, G, bx); DIS_G1(pg8::gemm_phase<EpiInNat<1>, TrimOrder<true>>(lds, g, S, E, nullptr);) }
                else { pg8::StaticOrder S; S.init(NTOK, 4096, G, bx); DIS_G1(pg8::gemm_phase<EpiInNat<1>, pg8::StaticOrder>(lds, g, S, E, nullptr);) }
            }
        } else if constexpr (sub == 1) {
            if constexpr ((l & 1) == 0) { DIS_EVEN(even_mixer_phase(A, lds, li);) } else { DIS_ODD(odd_mixer_phase(A, lds, l);) }
        } else if constexpr (sub == 2) {
            pg8::Gemm g{H, (const bf16_t*)(ws + WS_WOT) + (size_t)l * 1024 * 1024, NTOK, 1024, 1024};
            EpiY16 E{(bf16_t*)(ws + WS_P), 1024};
            if constexpr (l == 3) { TrimOrder<false> S; S.init2(4, G, bx); DIS_G3(pg8::gemm_phase<EpiY16, TrimOrder<false>>(lds, g, S, E, nullptr);) }
            else { pg8::StaticOrder S; S.init(NTOK, 1024, G, bx); DIS_G3(pg8::gemm_phase<EpiY16, pg8::StaticOrder>(lds, g, S, E, nullptr);) }
        } else { DIS_EW(ew_phase(A, l + 1);) }
    }
}
__global__ void __launch_bounds__(NTHREADS, 2) mk_fwd(Args A) {
    extern __shared__ __attribute__((aligned(16))) unsigned char lds_raw[];
    LAS unsigned char* lds = (LAS unsigned char*)lds_raw;
    cg::grid_group grid = cg::this_grid();
    volatile LAS unsigned* bst = (volatile LAS unsigned*)(lds + LDS_BYTES - 64);
    if (threadIdx.x < 2) bst[threadIdx.x] = 0u;
    __syncthreads();
    XcdBarrier xbar = xcd_barrier_post((unsigned*)(A.ws + WS_BAR), bst);
    int nsync = 0;
#ifndef REP_KIND
#define REP_KIND -1
#endif
#define KIND_OF(ph) ((ph) == 0 ? 4 : (ph) == 1 ? 9 : (((ph) - 2) & 3) == 0 ? 0 : (((ph) - 2) & 3) == 2 ? 3 : (((ph) - 2) & 3) == 3 ? 9 : (((((ph) - 2) >> 2) & 1) == 0 ? 1 : 2))
#define RUN(ph) if (A.ph_lo <= (ph) && (ph) < A.ph_hi) { run_phase<ph>(A, lds); if (KIND_OF(ph) == REP_KIND) { __syncthreads(); run_phase<ph>(A, lds); } if (KIND_OF(ph) == 1 && (REP_KIND == 5 || REP_KIND == 6)) { __syncthreads(); even_mixer_phase(A, lds, (((ph) - 2) >> 2) >> 1, REP_KIND - 4); } if ((ph) + 1 < A.ph_hi) { if (A.ph_hi > 1000) grid.sync(); else xcd_barrier(xbar); ++nsync;        if (REP_KIND == 7) { xcd_barrier(xbar); xcd_barrier(xbar); xcd_barrier(xbar); xcd_barrier(xbar); } } }
    RUN(0) RUN(1) RUN(2) RUN(3) RUN(4) RUN(5) RUN(6) RUN(7) RUN(8) RUN(9) RUN(10) RUN(11) RUN(12) RUN(13) RUN(14) RUN(15) RUN(16) RUN(17)
#undef RUN
}

#ifndef MK_MULTI
#define MK_MULTI 0
#endif
constexpr int NPHASES = 18;
extern "C" void kernel_launch(void* const* d_in, const int* in_sizes, int n_in, void* d_out, int out_size, void* d_ws, size_t ws_size, hipStream_t stream) {
    static int grid = 0;
    if (grid == 0) {
        if (n_in != 17 || ws_size < WS_END) { fprintf(stderr, "kernel_launch: unexpected inputs (n_in %d, ws %zu)\n", n_in, ws_size); grid = -1; return; }
        int dev = 0, cus = 0, per_cu = 0;
        hipGetDevice(&dev); hipDeviceGetAttribute(&cus, hipDeviceAttributeMultiprocessorCount, dev);
        if (hipFuncSetAttribute((const void*)mk_fwd, hipFuncAttributeMaxDynamicSharedMemorySize, LDS_BYTES) != hipSuccess) { fprintf(stderr, "kernel_launch: hipFuncSetAttribute failed\n"); grid = -1; return; }
        if (hipOccupancyMaxActiveBlocksPerMultiprocessor(&per_cu, (const void*)mk_fwd, NTHREADS, LDS_BYTES) != hipSuccess || per_cu < 1) { fprintf(stderr, "kernel_launch: occupancy query gave %d\n", per_cu); per_cu = 1; }
        (void)hipGetLastError();
        grid = cus * per_cu;
    }
    if (grid < 0) return;
    if (hipMemsetAsync((char*)d_ws + WS_BAR, 0, 16384, stream) != hipSuccess) { fprintf(stderr, "kernel_launch: memset failed\n"); return; }
    Args a{};
    for (int i = 0; i < 17; ++i) a.in[i] = (const float*)d_in[i];
    a.out = (float*)d_out; a.ws = (unsigned char*)d_ws;
#if MK_MULTI
    for (int ph = 0; ph < NPHASES; ++ph) { a.ph_lo = ph; a.ph_hi = ph + 1; hipLaunchKernelGGL(mk_fwd, dim3(grid), dim3(NTHREADS), LDS_BYTES, stream, a); }
#else
    a.ph_lo = 0; a.ph_hi = NPHASES;
    void* args[] = {&a};
    hipError_t e = hipLaunchCooperativeKernel((const void*)mk_fwd, dim3(grid), dim3(NTHREADS), args, LDS_BYTES, stream);
    if (e != hipSuccess) fprintf(stderr, "kernel_launch: cooperative launch failed: %s (grid %d)\n", hipGetErrorString(e), grid);
#endif
}
```

```cpp
#include <hip/hip_runtime.h>
#include <hip/hip_cooperative_groups.h>
#include <cstdio>
#include <cstdint>
namespace cg = cooperative_groups;
namespace pg8 {
#define PG8_LAS __attribute__((address_space(3)))
typedef unsigned short bf16_t;
typedef short bf16x8 __attribute__((ext_vector_type(8)));
typedef float f32x4 __attribute__((ext_vector_type(4)));
typedef unsigned u32x4 __attribute__((ext_vector_type(4)));
constexpr int BM = 256, BK = 64, HALF = 128, HTB = HALF * BK * 2  , STAGE_BYTES = 8 * HTB, NXCD = 8, WGM = 8;

__host__ __device__ __forceinline__ int lds_byte(int r, int c) { const int st = (r >> 4) * 2 + (c >> 5), rr = r & 15, cc = c & 31, ob = rr * 64 + cc * 2; return st * 1024 + (ob ^ (((ob >> 9) & 1) << 5)); }
__host__ __device__ __forceinline__ void stage_rc(int b, int& R, int& C) { const int st = b / 1024, sb = b % 1024, swz = sb ^ (((sb >> 9) & 1) << 5); R = (st >> 1) * 16 + swz / 64; C = (st & 1) * 32 + (swz % 64) / 2; }
__host__ __device__ __forceinline__ int perm32(int rho) { const int n = rho >> 4, i = rho & 15; return 8 * (i >> 2) + 4 * n + (i & 3); }

struct Unit { int pm, pn; };
struct Gemm { const bf16_t* A; const bf16_t* Bt; int M, N, K; };

struct StaticOrder {
    int nM, nN, nwg, G, c;
    __host__ __device__ void init(int M, int N, int G_, int c_) { nM = M / BM; nN = N / BM; nwg = nM * nN; G = G_; c = c_; }
    __host__ __device__ bool next(int i, Unit& u) const {
        const long L = (long)i * G + c; if (L >= nwg) return false;
        int wgid = (int)L; { const int q = nwg / NXCD, r = nwg % NXCD, xcd = wgid % NXCD, off = wgid / NXCD; wgid = (xcd < r ? xcd * (q + 1) : r * (q + 1) + (xcd - r) * q) + off; }
        const int nig = WGM * nN, gid = wgid / nig, fm = gid * WGM, gsz = (nM - fm) < WGM ? (nM - fm) : WGM;
        u.pm = fm + ((wgid % nig) % gsz); u.pn = (wgid % nig) / gsz; return true;
    }
    __device__ __forceinline__ void a_ready(const Unit&) const {}
    __device__ __forceinline__ void done(const Unit&) const {}
};
__device__ __forceinline__ unsigned cvt_pk_bf16(float lo, float hi) { unsigned r; asm volatile("v_cvt_pk_bf16_f32 %0, %1, %2" : "=v"(r) : "v"(lo), "v"(hi)); return r; }
typedef float f32x2 __attribute__((ext_vector_type(2)));
template <class Epi, class Sched, bool STAMP = false>
__device__ __forceinline__ void gemm_phase(PG8_LAS unsigned char* lds, const Gemm g, const Sched& S, const Epi& E, unsigned long long* stamps) {
    const int tid = threadIdx.x, wid = __builtin_amdgcn_readfirstlane(tid >> 6), lane = tid & 63, wr = wid >> 2, wc = wid & 3, fr = lane & 15, fq = lane >> 4;
    const int K = g.K, nt = K / BK;
    int ts_lo = 0, ts_hi = 0, nts = 0; const unsigned long long rt_entry = STAMP ? (unsigned long long)wall_clock64() : 0ull;
#define PG8_STAMP() do { if (STAMP && wid == 0 && nts < 64) { const unsigned long long _c = (unsigned long long)clock64(); \
        ts_lo = (lane == nts) ? (int)(unsigned)_c : ts_lo; ts_hi = (lane == nts) ? (int)(unsigned)(_c >> 32) : ts_hi; ++nts; } } while (0)
    PG8_STAMP();
    unsigned voffA[2], voffB[2];
#pragma unroll
    for (int i = 0; i < 2; ++i) { int R, C; stage_rc(tid * 16 + i * 8192, R, C); const int Rb = Epi::PERM ? ((R & ~31) + perm32(R & 31)) : R;
        voffA[i] = (unsigned)(R * K + C) * 2u; voffB[i] = (unsigned)(Rb * K + C) * 2u; }
    const size_t kstep = (size_t)(BK * 2);
    const size_t hstep = (size_t)HALF * K * 2;
    const size_t tstep = 2 * hstep;
    const unsigned ldsw = (unsigned)wid * 1024u;
    const int aoff = lds_byte(wr * 64 + fr, fq * 8), boff = lds_byte(wc * 32 + fr, fq * 8);
#define PG8_SA(b, h) (((b) * 2 + (h)) * HTB)
#define PG8_SB(b, h) ((4 + (b) * 2 + (h)) * HTB)
#define PG8_STAGE(bufoff, gbase, voff) do { _Pragma("unroll") for (int _i = 0; _i < 2; ++_i) \
        __builtin_amdgcn_global_load_lds((const unsigned*)((const char*)(gbase) + (voff)[_i]), (PG8_LAS unsigned*)(lds + (bufoff) + ldsw + _i * 8192), 16, 0, 0); } while (0)
#define PG8_LDA(dst, b, h) do { _Pragma("unroll") for (int m = 0; m < 4; ++m) _Pragma("unroll") for (int k = 0; k < 2; ++k) dst[m][k] = *(const PG8_LAS bf16x8*)(lds + PG8_SA(b, h) + aoff + m * 2048 + k * 1024); } while (0)
#define PG8_LDB(dst, b, h) do { _Pragma("unroll") for (int n = 0; n < 2; ++n) _Pragma("unroll") for (int k = 0; k < 2; ++k) dst[n][k] = *(const PG8_LAS bf16x8*)(lds + PG8_SB(b, h) + boff + n * 2048 + k * 1024); } while (0)
#define PG8_MMA(ai, bj, At, Bt) do { __builtin_amdgcn_s_setprio(1); _Pragma("unroll") for (int m = 0; m < 4; ++m) _Pragma("unroll") for (int n = 0; n < 2; ++n) _Pragma("unroll") for (int k = 0; k < 2; ++k) \
        acc[ai][bj][m][n] = __builtin_amdgcn_mfma_f32_16x16x32_bf16(Bt[n][k], At[m][k], acc[ai][bj][m][n], 0, 0, 0); __builtin_amdgcn_s_setprio(0); } while (0)
#define PG8_WAIT_V(n) asm volatile("s_waitcnt vmcnt(" #n ")" ::: "memory")
#define PG8_WAIT_L(n) asm volatile("s_waitcnt lgkmcnt(" #n ")" ::: "memory")
#define PG8_BAR __builtin_amdgcn_s_barrier()
#define PG8_SCHED __builtin_amdgcn_sched_barrier(0)
    Unit cur, nxt; int ui = 0;
    if (!S.next(0, cur)) return;
    f32x4 acc[2][2][4][2];
#pragma unroll
    for (int a = 0; a < 2; ++a)
#pragma unroll
        for (int b = 0; b < 2; ++b)
#pragma unroll
            for (int m = 0; m < 4; ++m)
#pragma unroll
                for (int n = 0; n < 2; ++n) acc[a][b][m][n] = (f32x4){0.f, 0.f, 0.f, 0.f};
    bf16x8 At[4][2], B0[2][2], B1[2][2];
    const char* cA = (const char*)g.A + (size_t)cur.pm * tstep; const char* cB = (const char*)g.Bt + (size_t)cur.pn * tstep;
    S.a_ready(cur);
    PG8_STAGE(PG8_SB(0, 0), cB, voffB); PG8_STAGE(PG8_SA(0, 0), cA, voffA); PG8_STAGE(PG8_SB(0, 1), cB + hstep, voffB); PG8_STAGE(PG8_SA(0, 1), cA + hstep, voffA);
    if (wr == 1) PG8_BAR;
    PG8_WAIT_V(4); PG8_BAR;
    PG8_STAGE(PG8_SB(1, 0), cB + kstep, voffB); PG8_STAGE(PG8_SA(1, 0), cA + kstep, voffA); PG8_STAGE(PG8_SB(1, 1), cB + hstep + kstep, voffB);
    PG8_WAIT_V(6); PG8_BAR;
    PG8_STAMP();
    for (;;) {
        const bool has_next = S.next(ui + 1, nxt);
        const char* nA = has_next ? (const char*)g.A + (size_t)nxt.pm * tstep : cA; const char* nB = has_next ? (const char*)g.Bt + (size_t)nxt.pn * tstep : cB;
        for (int t = 0; t < nt; t += 2) {
            const bool last = (t == nt - 2);
            const char* a1 = cA + (size_t)(t + 1) * kstep;
            const char* a2 = last ? nA : cA + (size_t)(t + 2) * kstep; const char* b2 = last ? nB : cB + (size_t)(t + 2) * kstep;
            const char* a3 = a2 + kstep; const char* b3 = b2 + kstep;
            if (last && has_next) S.a_ready(nxt);
            PG8_LDB(B0, 0, 0); PG8_SCHED; PG8_LDA(At, 0, 0); PG8_STAGE(PG8_SA(1, 1), a1 + hstep, voffA);
            PG8_WAIT_L(8); PG8_BAR; PG8_WAIT_L(0); PG8_MMA(0, 0, At, B0); PG8_BAR; PG8_SCHED;
            PG8_LDB(B1, 0, 1); PG8_STAGE(PG8_SB(0, 0), b2, voffB);
            PG8_BAR; PG8_WAIT_L(0); PG8_MMA(0, 1, At, B1); PG8_BAR;
            PG8_LDA(At, 0, 1); PG8_STAGE(PG8_SA(0, 0), a2, voffA);
            PG8_BAR; PG8_WAIT_L(0); PG8_MMA(1, 0, At, B0); PG8_BAR; PG8_SCHED;
            PG8_STAGE(PG8_SB(0, 1), b2 + hstep, voffB);
            PG8_WAIT_V(6); PG8_BAR; PG8_MMA(1, 1, At, B1); PG8_BAR;
            PG8_LDB(B0, 1, 0); PG8_SCHED; PG8_LDA(At, 1, 0); PG8_STAGE(PG8_SA(0, 1), a2 + hstep, voffA);
            PG8_WAIT_L(8); PG8_BAR; PG8_WAIT_L(0); PG8_MMA(0, 0, At, B0); PG8_BAR; PG8_SCHED;
            PG8_LDB(B1, 1, 1); PG8_STAGE(PG8_SB(1, 0), b3, voffB);
            PG8_BAR; PG8_WAIT_L(0); PG8_MMA(0, 1, At, B1); PG8_BAR;
            PG8_LDA(At, 1, 1); PG8_STAGE(PG8_SA(1, 0), a3, voffA);
            PG8_BAR; PG8_WAIT_L(0); PG8_MMA(1, 0, At, B0); PG8_BAR; PG8_SCHED;
            PG8_STAGE(PG8_SB(1, 1), b3 + hstep, voffB);
            PG8_WAIT_V(6); PG8_BAR; PG8_MMA(1, 1, At, B1); PG8_BAR;
        }
        PG8_STAMP();
        if constexpr (!Epi::AFTER_DRAIN) { E(acc, cur, wr, wc, fr, fq); S.done(cur); }
        PG8_STAMP();
        if (!has_next) break;
#pragma unroll
        for (int a = 0; a < 2; ++a)
#pragma unroll
            for (int b = 0; b < 2; ++b)
#pragma unroll
                for (int m = 0; m < 4; ++m)
#pragma unroll
                    for (int n = 0; n < 2; ++n) acc[a][b][m][n] = (f32x4){0.f, 0.f, 0.f, 0.f};
        cur = nxt; cA = nA; cB = nB; ++ui;
    }
    PG8_WAIT_V(0);
    if (wr == 0) PG8_BAR;
    PG8_BAR;
    if constexpr (Epi::AFTER_DRAIN) { E.fused(acc, cur, wr, wc, fr, fq, lds, wid, lane); S.done(cur); }
    PG8_STAMP();
    if (STAMP && wid == 0) { stamps[lane] = lane < nts ? (((unsigned long long)(unsigned)ts_hi << 32) | (unsigned)ts_lo) : 0ull;
        if (lane == 62) stamps[62] = rt_entry; if (lane == 63) stamps[63] = (unsigned long long)wall_clock64(); }
#undef PG8_STAMP
#undef PG8_SA
#undef PG8_SB
#undef PG8_STAGE
#undef PG8_LDA
#undef PG8_LDB
#undef PG8_MMA
#undef PG8_WAIT_V
#undef PG8_WAIT_L
#undef PG8_BAR
#undef PG8_SCHED
}
}

#define LAS __attribute__((address_space(3)))
using pg8::bf16_t; using pg8::bf16x8; using pg8::f32x4; using pg8::u32x4; using pg8::cvt_pk_bf16;
typedef unsigned u32x2 __attribute__((ext_vector_type(2)));
typedef float f32x2v __attribute__((ext_vector_type(2)));

constexpr int D = 1024, NB = 32, SEQ = 2048, CTXL = 256, SROW = 2304, NTOK = NB * SROW;
constexpr float EPS = 1e-6f;
constexpr int NTHREADS = 512;
constexpr int LDS_BYTES = 147456;
constexpr size_t MiB = 1u << 20;
constexpr size_t WS_BAR = 0;
constexpr size_t WS_MOD = 1 * MiB;
constexpr size_t WS_TABR = 3 * MiB;
constexpr size_t WS_TABRT = WS_TABR + 65536;
constexpr size_t WS_TABD = WS_TABRT + 65536;
constexpr size_t WS_WTE = 4 * MiB;
constexpr size_t WS_WTO = 16 * MiB;
constexpr size_t WS_WOT = 32 * MiB;
constexpr size_t WS_PWT = 40 * MiB;
constexpr size_t WS_XC = 48 * MiB;
constexpr size_t WS_H = 80 * MiB;
constexpr size_t WS_P = 224 * MiB;
constexpr size_t WS_T = 656 * MiB;
constexpr size_t WS_OF = 800 * MiB;
constexpr size_t WS_END = 944 * MiB;

struct Args { const float* in[17]; float* out; unsigned char* ws; int ph_lo, ph_hi; };

__device__ __forceinline__ float bf2f(unsigned short u) { return __uint_as_float(((unsigned)u) << 16); }
__device__ __forceinline__ float bflo(unsigned w) { return __uint_as_float(w << 16); }
__device__ __forceinline__ float bfhi(unsigned w) { return __uint_as_float(w & 0xffff0000u); }
__device__ __forceinline__ float silu_f(float x) { return x * __builtin_amdgcn_rcpf(1.0f + __expf(-x)); }
__device__ __forceinline__ f32x4 mfma16(bf16x8 a, bf16x8 b, f32x4 c) { return __builtin_amdgcn_mfma_f32_16x16x32_bf16(a, b, c, 0, 0, 0); }
template <int CTRL> __device__ __forceinline__ float dpp_f(float x) { return __builtin_bit_cast(float, __builtin_amdgcn_mov_dpp(__builtin_bit_cast(int, x), CTRL, 0xf, 0xf, true)); }
__device__ __forceinline__ float wave_sum(float v) {
    v += dpp_f<0xB1>(v);
    v += dpp_f<0x4E>(v);
    v += dpp_f<0x124>(v);
    v += dpp_f<0x128>(v);
    auto s = __builtin_amdgcn_permlane16_swap(__float_as_uint(v), __float_as_uint(v), false, false);
    v = __uint_as_float(s[0]) + __uint_as_float(s[1]);
    auto t = __builtin_amdgcn_permlane32_swap(__float_as_uint(v), __float_as_uint(v), false, false);
    return __uint_as_float(t[0]) + __uint_as_float(t[1]);
}

__device__ __forceinline__ float xrow16_max(float x) {
    auto s = __builtin_amdgcn_permlane16_swap(__float_as_uint(x), __float_as_uint(x), false, false);
    x = fmaxf(__uint_as_float(s[0]), __uint_as_float(s[1]));
    auto t = __builtin_amdgcn_permlane32_swap(__float_as_uint(x), __float_as_uint(x), false, false);
    return fmaxf(__uint_as_float(t[0]), __uint_as_float(t[1]));
}
__device__ __forceinline__ float xrow16_sum(float x) {
    auto s = __builtin_amdgcn_permlane16_swap(__float_as_uint(x), __float_as_uint(x), false, false);
    x = __uint_as_float(s[0]) + __uint_as_float(s[1]);
    auto t = __builtin_amdgcn_permlane32_swap(__float_as_uint(x), __float_as_uint(x), false, false);
    return __uint_as_float(t[0]) + __uint_as_float(t[1]);
}
typedef short s16x4 __attribute__((ext_vector_type(4)));
__device__ __forceinline__ bf16x8 ld_tr8(LAS const unsigned char* p0, LAS const unsigned char* p1) {
    const s16x4 a = __builtin_amdgcn_ds_read_tr16_b64_v4i16((LAS s16x4*)p0), b = __builtin_amdgcn_ds_read_tr16_b64_v4i16((LAS s16x4*)p1);
    return (bf16x8){a[0], a[1], a[2], a[3], b[0], b[1], b[2], b[3]};
}
template <int odd> struct EpiInNat {
    static constexpr bool PERM = true, AFTER_DRAIN = false;
    bf16_t* O; int ldc; const f32x4* tab; bf16_t* KB; bf16_t* VB;
    __device__ __forceinline__ void operator()(const f32x4 (&acc)[2][2][4][2], const pg8::Unit& u, int wr, int wc, int fr, int fq) const {
        const int pn = u.pn;
        const bool latent = (u.pm % 9) != 0;
        bool rope; float scl = 1.0f; int ax, i0, nf;
        if (odd) { rope = latent && pn < 8; ax = wc & 1; i0 = 4 * fq; nf = 16; }
        else { rope = latent && (pn < 2 || pn == 8 || pn == 9); ax = wc >> 1; i0 = 16 * (wc & 1) + 4 * fq; nf = 32; if (pn == 8 || pn == 9) scl = 0.08838834764831845f; }
        float frv[4];
#pragma unroll
        for (int e = 0; e < 4; ++e) frv[e] = exp2f(-(float)(2 * (i0 + e)) * (13.287712379549449f / (float)(2 * nf))) * 0.15915494309189535f;
        const int srow0 = (u.pm % 9) * 256 + wr * 64 + fr;
        const size_t row0 = (size_t)u.pm * 256 + wr * 64 + fr; const int col0 = pn * 256 + wc * 32 + 8 * fq;
        const bool ksec = odd && ((pn >= 4 && pn < 8) || pn >= 12);
        bf16_t* kb0 = (pn >= 12 ? VB : KB) + ((size_t)((u.pm / 9) * 8 + ((pn - 4) & 7) * 2) * SROW) * 128 + wc * 32 + 8 * fq;
        const int colw = (odd && pn >= 8) ? col0 - 1024 : col0;
        const size_t bjs = ksec ? (size_t)SROW * 128 : 128;
#pragma unroll
        for (int ai = 0; ai < 2; ++ai)
#pragma unroll
            for (int m = 0; m < 4; ++m) {
                f32x4 cs0 = {1.f, 0.f, 1.f, 0.f}, cs1 = {1.f, 0.f, 1.f, 0.f};
                if (rope) { const int t = srow0 + ai * 128 + m * 16 - 256; const float pos = (float)(ax ? (t & 63) : (t >> 6));
                    const float r0 = __builtin_amdgcn_fractf(pos * frv[0]), r1 = __builtin_amdgcn_fractf(pos * frv[1]), r2 = __builtin_amdgcn_fractf(pos * frv[2]), r3 = __builtin_amdgcn_fractf(pos * frv[3]);
                    cs0 = (f32x4){__builtin_amdgcn_cosf(r0), __builtin_amdgcn_sinf(r0), __builtin_amdgcn_cosf(r1), __builtin_amdgcn_sinf(r1)};
                    cs1 = (f32x4){__builtin_amdgcn_cosf(r2), __builtin_amdgcn_sinf(r2), __builtin_amdgcn_cosf(r3), __builtin_amdgcn_sinf(r3)}; }
                bf16_t* rowp = ksec ? kb0 + (size_t)(srow0 + ai * 128 + m * 16) * 128 : O + (row0 + ai * 128 + m * 16) * (size_t)ldc + colw;
#pragma unroll
                for (int bj = 0; bj < 2; ++bj) {
                    const f32x4 v0 = acc[ai][bj][m][0], v1 = acc[ai][bj][m][1];
                    const float a0 = (v0[0] * cs0[0] - v0[1] * cs0[1]) * scl, a1 = (v0[0] * cs0[1] + v0[1] * cs0[0]) * scl;
                    const float a2 = (v0[2] * cs0[2] - v0[3] * cs0[3]) * scl, a3 = (v0[2] * cs0[3] + v0[3] * cs0[2]) * scl;
                    const float b0 = (v1[0] * cs1[0] - v1[1] * cs1[1]) * scl, b1 = (v1[0] * cs1[1] + v1[1] * cs1[0]) * scl;
                    const float b2 = (v1[2] * cs1[2] - v1[3] * cs1[3]) * scl, b3 = (v1[2] * cs1[3] + v1[3] * cs1[2]) * scl;
                    u32x4 w; w.x = cvt_pk_bf16(a0, a1); w.y = cvt_pk_bf16(a2, a3); w.z = cvt_pk_bf16(b0, b1); w.w = cvt_pk_bf16(b2, b3);
                    *(u32x4*)(rowp + bj * bjs) = w;
                }
            }
    }
};
struct EpiY16 {
    static constexpr bool PERM = true, AFTER_DRAIN = false;
    bf16_t* C; int ldc;
    __device__ __forceinline__ void operator()(const f32x4 (&acc)[2][2][4][2], const pg8::Unit& u, int wr, int wc, int fr, int fq) const {
        const size_t row0 = (size_t)u.pm * 256 + wr * 64 + fr; const int col0 = u.pn * 256 + wc * 32 + 8 * fq;
#pragma unroll
        for (int ai = 0; ai < 2; ++ai)
#pragma unroll
            for (int m = 0; m < 4; ++m) { bf16_t* rowp = C + (row0 + ai * 128 + m * 16) * (size_t)ldc + col0;
#pragma unroll
                for (int bj = 0; bj < 2; ++bj) { const f32x4 v0 = acc[ai][bj][m][0], v1 = acc[ai][bj][m][1];
                    u32x4 w; w.x = cvt_pk_bf16(v0[0], v0[1]); w.y = cvt_pk_bf16(v0[2], v0[3]); w.z = cvt_pk_bf16(v1[0], v1[1]); w.w = cvt_pk_bf16(v1[2], v1[3]);
                    *(u32x4*)(rowp + bj * 128) = w; } }
    }
};

__device__ __forceinline__ int src_col(int mode, int n) {
    if (mode == 0) {
        const int sec = n >> 9, within = n & 511;
        const int base = (sec == 0) ? 0 : (sec == 1) ? 1536 : (sec == 2) ? 2048 : (sec == 3) ? 2560 : (sec == 4) ? 512 : 1024;
        if (sec == 0 || sec == 4) { const int head = within >> 7, np = within & 127, pp = np >> 1, which = np & 1, a = pp >> 5, i = pp & 31; return base + head * 128 + 64 * a + 32 * which + i; }
        return base + within;
    } else if (mode == 1) {
        const int sec = n >> 10, within = n & 1023;
        const int base = (sec == 0) ? 0 : (sec == 1) ? 1024 : (sec == 2) ? 3072 : 2048;
        if (sec < 2) { const int grp = within >> 6, np = within & 63, pp = np >> 1, which = np & 1, a = pp >> 4, i = pp & 15; return base + grp * 64 + 32 * a + 16 * which + i; }
        return base + within;
    }
    return n;
}
__device__ __forceinline__ void conv_w(bf16_t* dst, const float* src, int nrows, int K, int ld, int mode, int gtid, int gthreads) {
    const int items = nrows * (K >> 3);
    for (int it = gtid; it < items; it += gthreads) {
        const int n = it % nrows, k8 = it / nrows;
        const float* s = src + (size_t)(k8 * 8) * ld + src_col(mode, n);
        float v[8];
#pragma unroll
        for (int e = 0; e < 8; ++e) v[e] = s[(size_t)e * ld];
        u32x4 w; w.x = cvt_pk_bf16(v[0], v[1]); w.y = cvt_pk_bf16(v[2], v[3]); w.z = cvt_pk_bf16(v[4], v[5]); w.w = cvt_pk_bf16(v[6], v[7]);
        *(u32x4*)(dst + (size_t)n * K + k8 * 8) = w;
    }
}

__device__ __forceinline__ void prologue_phase(const Args& A, LAS unsigned char* lds) {
    const int tid = threadIdx.x, lane = tid & 63, wave = tid >> 6, G = gridDim.x, bx = blockIdx.x;
    unsigned char* ws = A.ws;
    float* MOD = (float*)(ws + WS_MOD);
    for (int u = bx; u < 192; u += G) {
        const int l = u / 48, n0 = (u % 48) * 64;
        LAS float* sl = (LAS float*)lds;
        for (int idx = tid; idx < 33 * 1024; idx += NTHREADS) { const int v = idx >> 10, k = idx & 1023; const float x = (v < 32) ? A.in[1][v * 1024 + k] : A.in[3][k]; sl[idx] = silu_f(x); }
        __syncthreads();
        float acc[33];
#pragma unroll
        for (int v = 0; v < 33; ++v) acc[v] = 0.f;
        const float* w = A.in[4] + ((size_t)l * 1024 + wave * 128) * 3072 + n0 + lane;
        for (int kk = 0; kk < 128; ++kk) { const float wv = w[(size_t)kk * 3072]; const int k = wave * 128 + kk;
#pragma unroll
            for (int v = 0; v < 33; ++v) acc[v] += sl[v * 1024 + k] * wv; }
        __syncthreads();
#pragma unroll
        for (int v = 0; v < 33; ++v) sl[(wave * 33 + v) * 64 + lane] = acc[v];
        __syncthreads();
        for (int idx = tid; idx < 33 * 64; idx += NTHREADS) { const int v = idx >> 6, ln = idx & 63; float s = 0.f;
#pragma unroll
            for (int w8 = 0; w8 < 8; ++w8) s += sl[(w8 * 33 + v) * 64 + ln];
            MOD[(size_t)(l * 33 + v) * 3072 + n0 + ln] = s + A.in[5][l * 3072 + n0 + ln]; }
        __syncthreads();
    }
    const int gtid = bx * NTHREADS + tid, gthreads = G * NTHREADS;
    for (int it = gtid; it < 3072; it += gthreads) {
        if (it < 2048) { const int pos = it >> 5, i = it & 31; const float fr = exp2f(-(float)(2 * i) * (13.287712379549449f / 64.0f)); const float ang = (float)pos * fr;
            const float c = cosf(ang), s = sinf(ang);
            float* t1 = (float*)(ws + WS_TABR) + 2 * (pos * 32 + i); t1[0] = c; t1[1] = s;
            float* t2 = (float*)(ws + WS_TABRT) + 2 * (i * 64 + pos); t2[0] = c; t2[1] = s; }
        else { const int j = it - 2048, pos = j >> 4, i = j & 15; const float fr = exp2f(-(float)(2 * i) * (13.287712379549449f / 32.0f)); const float ang = (float)pos * fr;
            float* t1 = (float*)(ws + WS_TABD) + 2 * (pos * 16 + i); t1[0] = cosf(ang); t1[1] = sinf(ang); }
    }
    for (int i = 0; i < 2; ++i) {
        conv_w((bf16_t*)(ws + WS_WTE) + (size_t)i * 3072 * 1024, A.in[8] + (size_t)i * 1024 * 3072, 3072, 1024, 3072, 0, gtid, gthreads);
        conv_w((bf16_t*)(ws + WS_WTO) + (size_t)i * 4096 * 1024, A.in[13] + (size_t)i * 1024 * 4096, 4096, 1024, 4096, 1, gtid, gthreads);
        conv_w((bf16_t*)(ws + WS_WOT) + (size_t)(2 * i) * 1024 * 1024, A.in[9] + (size_t)i * 1024 * 1024, 1024, 1024, 1024, 2, gtid, gthreads);
        conv_w((bf16_t*)(ws + WS_WOT) + (size_t)(2 * i + 1) * 1024 * 1024, A.in[14] + (size_t)i * 1024 * 1024, 1024, 1024, 1024, 2, gtid, gthreads);
    }
    for (int m = 0; m < 8; ++m) conv_w((bf16_t*)(ws + WS_PWT) + m * 16384, A.in[11] + m * 16384, 128, 128, 128, 2, gtid, gthreads);
}

__device__ __forceinline__ void ew_phase(const Args& A, int l) {
    const int tid = threadIdx.x, lane = tid & 63, wave = tid >> 6;
    unsigned char* ws = A.ws;
    const float* MOD = (const float*)(ws + WS_MOD); const bf16_t* Y = (const bf16_t*)(ws + WS_P); bf16_t* H = (bf16_t*)(ws + WS_H); float* XC = (float*)(ws + WS_XC);
    const int nw = gridDim.x * 8;
    constexpr int NR = 4;
    for (int Ra = (blockIdx.x * 8 + wave) * NR; Ra < NTOK; Ra += NR * nw) {
        int Rr[NR]; bool act[NR]; const float* xin[NR]; float* xout[NR]; int vv[NR];
#pragma unroll
        for (int q = 0; q < NR; ++q) Rr[q] = Ra + q;
#pragma unroll
        for (int q = 0; q < NR; ++q) {
            const int R = Rr[q] < NTOK ? Rr[q] : Ra; const int b = R / SROW, s = R - b * SROW; const bool isctx = s < CTXL;
            act[q] = (Rr[q] < NTOK) && !(l == 4 && isctx); Rr[q] = R; vv[q] = isctx ? 32 : b;
            if (isctx) { const size_t o = ((size_t)b * CTXL + s) * D; xout[q] = XC + o; xin[q] = (l <= 1) ? A.in[2] + o : xout[q]; }
            else { const size_t o = ((size_t)b * SEQ + (s - CTXL)) * D; xout[q] = A.out + o; xin[q] = (l <= 1) ? A.in[0] + o : xout[q]; }
        }
        f32x4 xv[NR][4]; u32x2 yr[NR][4];
#pragma unroll
        for (int q = 0; q < NR; ++q)
#pragma unroll
            for (int k = 0; k < 4; ++k) { xv[q][k] = __builtin_nontemporal_load((const f32x4*)(xin[q] + 4 * lane + 256 * k)); if (l > 0) yr[q][k] = __builtin_nontemporal_load((const u32x2*)(Y + (size_t)Rr[q] * D + 4 * lane + 256 * k)); }
#pragma unroll
        for (int q = 0; q < NR; ++q) {
            if (l > 0) {
                f32x4 yv[4]; float ss = 0.f;
#pragma unroll
                for (int k = 0; k < 4; ++k) { yv[k] = (f32x4){bflo(yr[q][k].x), bfhi(yr[q][k].x), bflo(yr[q][k].y), bfhi(yr[q][k].y)}; ss += yv[k][0] * yv[k][0] + yv[k][1] * yv[k][1] + yv[k][2] * yv[k][2] + yv[k][3] * yv[k][3]; }
                ss = wave_sum(ss); const float r = rsqrtf(ss * (1.0f / D) + EPS);
                const float* gate = MOD + (size_t)((l - 1) * 33 + vv[q]) * 3072 + 2048; const float* np = A.in[7] + (l - 1) * D;
#pragma unroll
                for (int k = 0; k < 4; ++k) { const f32x4 g = *(const f32x4*)(gate + 4 * lane + 256 * k), n = *(const f32x4*)(np + 4 * lane + 256 * k);
                    xv[q][k] += g * (yv[k] * r * n); if (act[q]) __builtin_nontemporal_store(xv[q][k], (f32x4*)(xout[q] + 4 * lane + 256 * k)); }
            }
            if (l < 4) {
                float ss = 0.f;
#pragma unroll
                for (int k = 0; k < 4; ++k) ss += xv[q][k][0] * xv[q][k][0] + xv[q][k][1] * xv[q][k][1] + xv[q][k][2] * xv[q][k][2] + xv[q][k][3] * xv[q][k][3];
                ss = wave_sum(ss); const float r = rsqrtf(ss * (1.0f / D) + EPS);
                const float* md = MOD + (size_t)(l * 33 + vv[q]) * 3072; const float* np = A.in[6] + l * D;
#pragma unroll
                for (int k = 0; k < 4; ++k) { const f32x4 sh = *(const f32x4*)(md + 4 * lane + 256 * k), sc = *(const f32x4*)(md + 1024 + 4 * lane + 256 * k), n = *(const f32x4*)(np + 4 * lane + 256 * k);
                    const f32x4 h = xv[q][k] * r * n * (sc + 1.0f) + sh;
                    u32x2 w; w.x = cvt_pk_bf16(h[0], h[1]); w.y = cvt_pk_bf16(h[2], h[3]);
                    if (act[q]) *(u32x2*)(H + (size_t)Rr[q] * D + 4 * lane + 256 * k) = w; }
            }
        }
    }
}

constexpr int RP = 288;
__device__ __forceinline__ bf16x8 ld_frag16(LAS const unsigned char* p) { return *(LAS const bf16x8*)p; }
__device__ __forceinline__ bf16x8 ld_frag8x2(LAS const unsigned char* p0, LAS const unsigned char* p1) {
    const u32x2 a = *(LAS const u32x2*)p0, b = *(LAS const u32x2*)p1; u32x4 w; w.x = a.x; w.y = a.y; w.z = b.x; w.w = b.y; return __builtin_bit_cast(bf16x8, w); }

__device__ __forceinline__ void stage128(LAS unsigned char* dst, const bf16_t* src, size_t gp, int tid) {
    u32x4 r[4];
#pragma unroll
    for (int k = 0; k < 4; ++k) { const int q = tid + NTHREADS * k, row = q >> 4, cc = q & 15; r[k] = *(const u32x4*)(src + (size_t)row * gp + cc * 8); }
#pragma unroll
    for (int k = 0; k < 4; ++k) { const int q = tid + NTHREADS * k, row = q >> 4, cc = q & 15; *(LAS u32x4*)(dst + row * RP + cc * 16) = r[k]; }
}

__device__ __forceinline__ void retention_unit(const Args& A, LAS unsigned char* lds, int unit, int li  ) {
    const int tid = threadIdx.x, lane = tid & 63, w = __builtin_amdgcn_readfirstlane(tid >> 6), fr = lane & 15, fq = lane >> 4;
    const int b = unit >> 2, h = unit & 3;
    unsigned char* ws = A.ws;
    const bf16_t* Pn = (const bf16_t*)(ws + WS_P); float* OF = (float*)(ws + WS_OF); bf16_t* A2 = (bf16_t*)(ws + WS_H);
    LAS unsigned char* Ks = lds; LAS unsigned char* Vs = lds + 128 * RP; LAS unsigned char* Ss = lds + 2 * 128 * RP;
    const int trq = 4 * fq + (fr >> 2), trp = 8 * (fr & 3);
    LAS float* KD = (LAS float*)(lds + 3 * 128 * RP); LAS float* DT = KD + 128;
    { const float l2f_ = -__expf(A.in[10][(li * 2 + 0) * 4 + h]) * 1.4426950408889634f, l2b_ = -__expf(A.in[10][(li * 2 + 1) * 4 + h]) * 1.4426950408889634f;
      __syncthreads();
      for (int e = tid; e < 4 * 264; e += NTHREADS) { const int a = e / 264, m = e - a * 264 + a, dl = 127 - m;
          DT[e] = (dl >= 0) ? exp2f(l2f_ * (float)dl) : exp2f(-l2b_ * (float)dl); } }

    const int iloc = 16 * w + fr;
    LAS const float* dtp = DT + ((127 - iloc) & 3) * 264 + ((127 - iloc) & ~3) + 4 * fq;
#pragma unroll 1
    for (int dir = 0; dir < 2; ++dir) {
        const float l2 = -__expf(A.in[10][(li * 2 + dir) * 4 + h]) * 1.4426950408889634f;
        const float cdec = exp2f(l2 * 128.0f);
        const float qd = exp2f(l2 * (dir == 0 ? (float)(iloc + 1) : (float)(128 - iloc)));
        f32x4 accS[8];
#pragma unroll
        for (int dt = 0; dt < 8; ++dt) accS[dt] = (f32x4){0.f, 0.f, 0.f, 0.f};
        __syncthreads();
        if (tid < 128) KD[tid] = exp2f(l2 * (dir == 0 ? (float)(127 - tid) : (float)tid));
        for (int q = tid; q < 128 * 16; q += NTHREADS) *(LAS u32x4*)(Ss + (q >> 4) * RP + (q & 15) * 16) = (u32x4){0u, 0u, 0u, 0u};
#pragma unroll 1
        for (int step = 0; step < 18; ++step) {
            const int c = (dir == 0) ? step : (step < 2 ? 1 - step : 19 - step);
            const size_t R0 = (size_t)b * SROW + c * 128;
            LAS const float* dtpv = dtp; LAS const float* kdv = KD + 4 * fq; asm volatile("" : "+v"(dtpv), "+v"(kdv));
            bf16x8 Qf[4];
            { u32x4 r0[4], r1[4];
              const bf16_t* s0 = Pn + R0 * 3072 + 2048 + h * 128;
#pragma unroll
              for (int k = 0; k < 4; ++k) { const int q = tid + NTHREADS * k, row = q >> 4, cc = q & 15; r0[k] = *(const u32x4*)(s0 + (size_t)row * 3072 + cc * 8); r1[k] = *(const u32x4*)(s0 + 512 + (size_t)row * 3072 + cc * 8); }
              const bf16_t* qp = Pn + (R0 + iloc) * 3072 + h * 128 + 8 * fq;
#pragma unroll
              for (int ds = 0; ds < 4; ++ds) Qf[ds] = *(const bf16x8*)(qp + 32 * ds);
#pragma unroll
              for (int k = 0; k < 4; ++k) { const int q = tid + NTHREADS * k, row = q >> 4, cc = q & 15; *(LAS u32x4*)(Ks + row * RP + cc * 16) = r0[k]; *(LAS u32x4*)(Vs + row * RP + cc * 16) = r1[k]; } }
            __syncthreads();
            f32x4 accO[8];
#pragma unroll
            for (int hb = 0; hb < 4; ++hb) { bf16x8 fa[8];
#pragma unroll
                for (int q = 0; q < 8; ++q) fa[q] = ld_frag16(Ss + (16 * (2 * hb + (q >> 2)) + fr) * RP + (32 * (q & 3) + 8 * fq) * 2);
                __builtin_amdgcn_sched_barrier(0);
#pragma unroll
                for (int v2 = 0; v2 < 2; ++v2) { f32x4 a = {0.f, 0.f, 0.f, 0.f};
#pragma unroll
                    for (int ds = 0; ds < 4; ++ds) a = mfma16(fa[v2 * 4 + ds], Qf[ds], a);
                    accO[2 * hb + v2] = a * qd; }
                __builtin_amdgcn_sched_barrier(0); }
            if (dir == 1) {
#pragma unroll
            for (int jp = 0; jp < 4; ++jp) { float pv[8];
                bf16x8 fk[8];
#pragma unroll
                for (int q = 0; q < 8; ++q) fk[q] = ld_frag16(Ks + (16 * (2 * jp + (q >> 2)) + fr) * RP + (32 * (q & 3) + 8 * fq) * 2);
                __builtin_amdgcn_sched_barrier(0);
#pragma unroll
                for (int hf = 0; hf < 2; ++hf) { const int jt = 2 * jp + hf; f32x4 sc = {0.f, 0.f, 0.f, 0.f};
#pragma unroll
                    for (int ds = 0; ds < 4; ++ds) sc = mfma16(fk[hf * 4 + ds], Qf[ds], sc);
                    { const f32x4 dw = *(LAS const f32x4*)(dtpv + 16 * jt);
#pragma unroll
                      for (int r = 0; r < 4; ++r) pv[4 * hf + r] = sc[r] * dw[r]; } }
                u32x4 wv; wv.x = cvt_pk_bf16(pv[0], pv[1]); wv.y = cvt_pk_bf16(pv[2], pv[3]); wv.z = cvt_pk_bf16(pv[4], pv[5]); wv.w = cvt_pk_bf16(pv[6], pv[7]);
                const bf16x8 PBj = __builtin_bit_cast(bf16x8, wv);
                bf16x8 fv[8];
#pragma unroll
                for (int vt = 0; vt < 8; ++vt) { LAS const unsigned char* vp = Vs + (32 * jp + trq) * RP + vt * 32 + trp; fv[vt] = ld_tr8(vp, vp + 16 * RP); }
                __builtin_amdgcn_sched_barrier(0);
#pragma unroll
                for (int vt = 0; vt < 8; ++vt) accO[vt] = mfma16(fv[vt], PBj, accO[vt]);
                __builtin_amdgcn_sched_barrier(0); }
            }
            { float* ofp = OF + (R0 + iloc) * 512 + h * 128 + 4 * fq;
              if (dir == 0) {
#pragma unroll
                  for (int vt = 0; vt < 8; ++vt) *(f32x4*)(ofp + 16 * vt) = accO[vt];
              } else {
                  float s1 = 0.f;
#pragma unroll
                  for (int vt = 0; vt < 8; ++vt) { accO[vt] += *(const f32x4*)(ofp + 16 * vt); s1 += (accO[vt][0] + accO[vt][1]) + (accO[vt][2] + accO[vt][3]); }
                  s1 = xrow16_sum(s1);
                  const float mu = s1 * (1.0f / 128.0f); float s2 = 0.f;
#pragma unroll
                  for (int vt = 0; vt < 8; ++vt) { const f32x4 d = accO[vt] - mu; s2 += (d[0] * d[0] + d[1] * d[1]) + (d[2] * d[2] + d[3] * d[3]); }
                  s2 = xrow16_sum(s2);
                  const float rs = rsqrtf(s2 * (1.0f / 128.0f) + EPS);
                  const bf16_t* gp = Pn + (R0 + iloc) * 3072 + 512 + h * 128 + 4 * fq; bf16_t* op = A2 + (R0 + iloc) * 1024 + h * 128 + 4 * fq;
#pragma unroll
                  for (int vt = 0; vt < 8; ++vt) { const u32x2 g = *(const u32x2*)(gp + 16 * vt);
                      const float o0 = (accO[vt][0] - mu) * rs * silu_f(bflo(g.x)), o1 = (accO[vt][1] - mu) * rs * silu_f(bfhi(g.x));
                      const float o2 = (accO[vt][2] - mu) * rs * silu_f(bflo(g.y)), o3 = (accO[vt][3] - mu) * rs * silu_f(bfhi(g.y));
                      u32x2 wv; wv.x = cvt_pk_bf16(o0, o1); wv.y = cvt_pk_bf16(o2, o3); *(u32x2*)(op + 16 * vt) = wv; }
              } }
            bf16x8 Vd[4];
#pragma unroll
            for (int js = 0; js < 4; ++js) { LAS const unsigned char* vp = Vs + (32 * js + trq) * RP + w * 32 + trp; const u32x4 raw = __builtin_bit_cast(u32x4, ld_tr8(vp, vp + 16 * RP)); float kd[8];
                { const f32x4 k0 = *(LAS const f32x4*)(kdv + 32 * js), k1 = *(LAS const f32x4*)(kdv + 32 * js + 16); kd[0] = k0[0]; kd[1] = k0[1]; kd[2] = k0[2]; kd[3] = k0[3]; kd[4] = k1[0]; kd[5] = k1[1]; kd[6] = k1[2]; kd[7] = k1[3]; }
                u32x4 wv; wv.x = cvt_pk_bf16(bflo(raw.x) * kd[0], bfhi(raw.x) * kd[1]); wv.y = cvt_pk_bf16(bflo(raw.y) * kd[2], bfhi(raw.y) * kd[3]);
                wv.z = cvt_pk_bf16(bflo(raw.z) * kd[4], bfhi(raw.z) * kd[5]); wv.w = cvt_pk_bf16(bflo(raw.w) * kd[6], bfhi(raw.w) * kd[7]);
                Vd[js] = __builtin_bit_cast(bf16x8, wv); }
#pragma unroll
            for (int hb = 0; hb < 4; ++hb) { bf16x8 fk[8];
#pragma unroll
                for (int q = 0; q < 8; ++q) { LAS const unsigned char* kp = Ks + (32 * (q & 3) + trq) * RP + (2 * hb + (q >> 2)) * 32 + trp; fk[q] = ld_tr8(kp, kp + 16 * RP); }
                __builtin_amdgcn_sched_barrier(0);
#pragma unroll
                for (int d2 = 0; d2 < 2; ++d2) { f32x4 a = accS[2 * hb + d2] * cdec;
#pragma unroll
                    for (int js = 0; js < 4; ++js) a = mfma16(fk[d2 * 4 + js], Vd[js], a);
                    accS[2 * hb + d2] = a; }
                __builtin_amdgcn_sched_barrier(0); }
            __syncthreads();
#pragma unroll
            for (int dt = 0; dt < 8; ++dt) { u32x2 wv; wv.x = cvt_pk_bf16(accS[dt][0], accS[dt][1]); wv.y = cvt_pk_bf16(accS[dt][2], accS[dt][3]);
                *(LAS u32x2*)(Ss + (16 * w + fr) * RP + (16 * dt + 4 * fq) * 2) = wv; }
        }
    }
    __syncthreads();
}

constexpr int POOL_PIN = 0, POOL_DSM = 144 * RP, POOL_PW = POOL_DSM + 128 * RP;
template <int GI> __device__ __forceinline__ void pool_body(const Args& A, LAS unsigned char* lds, int seg, int li) {
    constexpr int win = 2 << GI, hw = win >> 1, g = GI;
    const int tid = threadIdx.x, lane = tid & 63, w = tid >> 6, fr = lane & 15, fq = lane >> 4;
    unsigned char* ws = A.ws;
    const bf16_t* Pn = (const bf16_t*)(ws + WS_P); bf16_t* A2 = (bf16_t*)(ws + WS_H);
    const size_t R0 = (size_t)seg * 128; const int s0 = (int)(R0 % SROW); const bool isctx = s0 < CTXL;
    const int TT = isctx ? CTXL : SEQ, t0 = isctx ? s0 : s0 - CTXL; const size_t Rseq = R0 - t0;
    LAS unsigned char* pin = lds + POOL_PIN; LAS unsigned char* dsm = lds + POOL_DSM; LAS const unsigned char* PWs = lds + POOL_PW;
    u32x4 rr[5];
#pragma unroll
    for (int k = 0; k < 5; ++k) { const int q = tid + NTHREADS * k, row = q >> 4, cc = q & 15, t = t0 - 8 + row; const bool ok = (q < 144 * 16) && t >= 0 && t < TT;
        rr[k] = (u32x4){0u, 0u, 0u, 0u}; if (ok) rr[k] = *(const u32x4*)(Pn + (Rseq + t) * 3072 + 1024 + g * 128 + cc * 8); }
    const size_t R = R0 + 16 * w + fr;
    const bf16_t* gp = Pn + R * 3072 + 1536 + g * 128 + 4 * fq;
    u32x2 gg[8];
#pragma unroll
    for (int dt = 0; dt < 8; ++dt) gg[dt] = *(const u32x2*)(gp + 16 * dt);
    __syncthreads();
#pragma unroll
    for (int k = 0; k < 5; ++k) { const int q = tid + NTHREADS * k; if (q < 144 * 16) *(LAS u32x4*)(pin + (q >> 4) * RP + (q & 15) * 16) = rr[k]; }
    __syncthreads();
#pragma unroll
    for (int k = 0; k < 4; ++k) { const int q = tid + NTHREADS * k, tl = q >> 4, cc = q & 15, t = t0 + tl;
        const int lo = max(t - hw, 0), hi = min(t + hw - 1, TT - 1);
        float sm[8];
#pragma unroll
        for (int e = 0; e < 8; ++e) sm[e] = 0.f;
#pragma unroll
        for (int ww = 0; ww < win; ++ww) { const u32x4 r = *(LAS const u32x4*)(pin + (tl + 8 - hw + ww) * RP + cc * 16);
            sm[0] += bflo(r.x); sm[1] += bfhi(r.x); sm[2] += bflo(r.y); sm[3] += bfhi(r.y); sm[4] += bflo(r.z); sm[5] += bfhi(r.z); sm[6] += bflo(r.w); sm[7] += bfhi(r.w); }
        const float inv = 1.0f / (float)(hi - lo + 1);
        const u32x4 c = *(LAS const u32x4*)(pin + (tl + 8) * RP + cc * 16);
        u32x4 wv; wv.x = cvt_pk_bf16(sm[0] * inv - bflo(c.x), sm[1] * inv - bfhi(c.x)); wv.y = cvt_pk_bf16(sm[2] * inv - bflo(c.y), sm[3] * inv - bfhi(c.y));
        wv.z = cvt_pk_bf16(sm[4] * inv - bflo(c.z), sm[5] * inv - bfhi(c.z)); wv.w = cvt_pk_bf16(sm[6] * inv - bflo(c.w), sm[7] * inv - bfhi(c.w));
        *(LAS u32x4*)(dsm + tl * RP + cc * 16) = wv; }
    __syncthreads();
    bf16x8 Bf[4];
#pragma unroll
    for (int cs = 0; cs < 4; ++cs) Bf[cs] = ld_frag16(dsm + (16 * w + fr) * RP + (32 * cs + 8 * fq) * 2);
    const float* psc = A.in[12] + li * 512 + g * 128 + 4 * fq;
    bf16_t* op = A2 + R * 1024 + 512 + g * 128 + 4 * fq;
#pragma unroll
    for (int hb = 0; hb < 4; ++hb) { bf16x8 fa[8];
#pragma unroll
        for (int q = 0; q < 8; ++q) fa[q] = ld_frag16(PWs + (16 * (2 * hb + (q >> 2)) + fr) * RP + (32 * (q & 3) + 8 * fq) * 2);
        __builtin_amdgcn_sched_barrier(0);
#pragma unroll
        for (int d2 = 0; d2 < 2; ++d2) { const int dt = 2 * hb + d2; f32x4 a = {0.f, 0.f, 0.f, 0.f};
#pragma unroll
            for (int cs = 0; cs < 4; ++cs) a = mfma16(fa[d2 * 4 + cs], Bf[cs], a);
            const f32x4 sc = *(const f32x4*)(psc + 16 * dt);
            u32x2 wv; wv.x = cvt_pk_bf16(a[0] * sc[0] * silu_f(bflo(gg[dt].x)), a[1] * sc[1] * silu_f(bfhi(gg[dt].x))); wv.y = cvt_pk_bf16(a[2] * sc[2] * silu_f(bflo(gg[dt].y)), a[3] * sc[3] * silu_f(bfhi(gg[dt].y)));
            *(u32x2*)(op + 16 * dt) = wv; }
        __builtin_amdgcn_sched_barrier(0); }
}
__device__ __forceinline__ void pool_stage_w(const Args& A, LAS unsigned char* lds, int g, int li) {
    const bf16_t* PW = (const bf16_t*)(A.ws + WS_PWT) + (size_t)(li * 4 + g) * 16384;
    __syncthreads();
    for (int q = threadIdx.x; q < 128 * 16; q += NTHREADS) *(LAS u32x4*)(lds + POOL_PW + (q >> 4) * RP + (q & 15) * 16) = *(const u32x4*)(PW + q * 8);
    __syncthreads();
}
__device__ __forceinline__ void pool_unit(const Args& A, LAS unsigned char* lds, int unit, int li, int& cur_g) {
    const int seg = unit >> 2, g = unit & 3;
    if (g != cur_g) { pool_stage_w(A, lds, g, li); cur_g = g; }
    switch (g) { case 0: pool_body<0>(A, lds, seg, li); break; case 1: pool_body<1>(A, lds, seg, li); break; case 2: pool_body<2>(A, lds, seg, li); break; default: pool_body<3>(A, lds, seg, li); break; }
}

#ifdef NO_RET
#define DIS_RET(...)
#else
#define DIS_RET(...) __VA_ARGS__
#endif
#ifdef NO_POOL
#define DIS_POOL(...)
#else
#define DIS_POOL(...) __VA_ARGS__
#endif
__device__ __forceinline__ void even_mixer_phase(const Args& A, LAS unsigned char* lds, int li, int part = 0) {
    const int G = gridDim.x, bx = blockIdx.x;
    const int nret = 128; int cur_g = -1;
    if (G > nret) {
        if (bx < nret) { if (part != 2) { DIS_RET(retention_unit(A, lds, bx, li);) } }
        else if (part != 1) for (int u = bx - nret; u < 576 * 4; u += G - nret) { DIS_POOL(pool_unit(A, lds, u, li, cur_g);) }
    } else {
        if (part != 2) for (int u = bx; u < nret; u += G) { DIS_RET(retention_unit(A, lds, u, li);) }
        if (part != 1) for (int u = bx; u < 576 * 4; u += G) { DIS_POOL(pool_unit(A, lds, u, li, cur_g);) }
    }
}

constexpr int KT_BYTES = 64 * 256, VT_BYTES = 64 * 256, AV_OFF = 2 * KT_BYTES;

__device__ __forceinline__ void attn_unit(const Args& A, LAS unsigned char* lds, int unit, int next_unit, bool staged, int l, float lam, float lam_init) {
    const int tid = threadIdx.x, lane = tid & 63, w = __builtin_amdgcn_readfirstlane(tid >> 6), fr = lane & 15, fq = lane >> 4;
    const int li = l >> 1;
    int b, h, qrow0, nkt;
    if (unit < 4096) { const int bh = unit >> 4, qb = unit & 15; b = bh >> 3; h = bh & 7; qrow0 = CTXL + qb * 128; nkt = 36; }
    else { const int u2 = unit - 4096, bh = u2 >> 1, qb = u2 & 1; b = bh >> 3; h = bh & 7; qrow0 = qb * 128; nkt = 4; }
    unsigned char* ws = A.ws;
    const bf16_t* Pn = (const bf16_t*)(ws + WS_P); bf16_t* A2 = (bf16_t*)(ws + WS_H);
    const size_t Rb = (size_t)b * SROW; const size_t Rq = Rb + qrow0 + 16 * w + fr;
    const float cs = 0.125f * 1.4426950408889634f;
    bf16x8 Qf[2][2];
#pragma unroll
    for (int mp = 0; mp < 2; ++mp)
#pragma unroll
        for (int ds = 0; ds < 2; ++ds) { const u32x4 raw = *(const u32x4*)(Pn + Rq * 2048 + h * 128 + mp * 64 + 32 * ds + 8 * fq); u32x4 wq;
            wq.x = cvt_pk_bf16(bflo(raw.x) * cs, bfhi(raw.x) * cs); wq.y = cvt_pk_bf16(bflo(raw.y) * cs, bfhi(raw.y) * cs); wq.z = cvt_pk_bf16(bflo(raw.z) * cs, bfhi(raw.z) * cs); wq.w = cvt_pk_bf16(bflo(raw.w) * cs, bfhi(raw.w) * cs);
            Qf[mp][ds] = __builtin_bit_cast(bf16x8, wq); }
    const bf16_t* kbase = (const bf16_t*)(ws + WS_OF) + (size_t)(b * 8 + h) * SROW * 128; const bf16_t* vbase = (const bf16_t*)(ws + WS_T) + (size_t)(b * 8 + h) * SROW * 128;
    int nb_ = 0, nh_ = 0;
    if (next_unit >= 0) { const int nbh = (next_unit < 4096) ? (next_unit >> 4) : ((next_unit - 4096) >> 1); nb_ = nbh >> 3; nh_ = nbh & 7; }
    const bf16_t* nkbase = (const bf16_t*)(ws + WS_OF) + (size_t)(nb_ * 8 + nh_) * SROW * 128; const bf16_t* nvbase = (const bf16_t*)(ws + WS_T) + (size_t)(nb_ * 8 + nh_) * SROW * 128;
    int ksrc[2], vsrc[2];
#pragma unroll
    for (int i = 0; i < 2; ++i) { const int row = (i * 8 + w) * 4 + (lane >> 4), p = lane & 15; ksrc[i] = row * 128 + (p ^ (row & 15)) * 8; vsrc[i] = row * 128 + (p ^ (2 * (row & 7))) * 8; }
#define ATT_DMA(t, kbuf, vbuf) do { const size_t to_ = (size_t)(t) * 8192; \
        _Pragma("unroll") for (int i_ = 0; i_ < 2; ++i_) { \
            __builtin_amdgcn_global_load_lds((const unsigned*)(kbase + to_ + ksrc[i_]), (LAS unsigned*)(lds + (kbuf) * KT_BYTES + (i_ * 8 + w) * 1024), 16, 0, 0); \
            __builtin_amdgcn_global_load_lds((const unsigned*)(vbase + to_ + vsrc[i_]), (LAS unsigned*)(lds + AV_OFF + (vbuf) * VT_BYTES + (i_ * 8 + w) * 1024), 16, 0, 0); } } while (0)
    int koff[2][2];
#pragma unroll
    for (int mp = 0; mp < 2; ++mp)
#pragma unroll
        for (int ds = 0; ds < 2; ++ds) koff[mp][ds] = fr * 256 + (((mp * 8 + ds * 4 + fq) ^ fr) * 16);
    const int gg32 = (4 * (fq & 1) + (fr >> 2)) * 32;
    const int vlane = (4 * fq + (fr >> 2)) * 256 + ((fr & 3) >> 1) * 16 + (fr & 1) * 8;
    f32x4 acc[2][8];
#pragma unroll
    for (int mp = 0; mp < 2; ++mp)
#pragma unroll
        for (int vt = 0; vt < 8; ++vt) acc[mp][vt] = (f32x4){0.f, 0.f, 0.f, 0.f};
    float lsum[2] = {0.f, 0.f}; f32x4 negm[2] = {{0.f, 0.f, 0.f, 0.f}, {0.f, 0.f, 0.f, 0.f}};
#define ATT_TILE(KOFF, VOFF, first) do { LAS const unsigned char* kb = lds + (KOFF); LAS const unsigned char* vb_ = lds + (VOFF) + vlane; \
        f32x4 s[2][4]; \
        _Pragma("unroll") for (int mp = 0; mp < 2; ++mp) { bf16x8 kf[8]; \
            _Pragma("unroll") for (int q = 0; q < 8; ++q) kf[q] = ld_frag16(kb + (q >> 1) * 4096 + koff[mp][q & 1]); \
            __builtin_amdgcn_sched_barrier(0); \
            _Pragma("unroll") for (int jt = 0; jt < 4; ++jt) s[mp][jt] = mfma16(kf[jt * 2 + 1], Qf[mp][1], mfma16(kf[jt * 2], Qf[mp][0], negm[mp])); \
            __builtin_amdgcn_sched_barrier(0); } \
        bf16x8 PB[2][2]; float ps[2]; \
        _Pragma("unroll") for (int mp = 0; mp < 2; ++mp) { float a_ = 0.f; f32x4 p[4]; \
            _Pragma("unroll") for (int jt = 0; jt < 4; ++jt) _Pragma("unroll") for (int r = 0; r < 4; ++r) { p[jt][r] = __builtin_amdgcn_exp2f(s[mp][jt][r]); a_ += p[jt][r]; } \
            ps[mp] = a_; \
            _Pragma("unroll") for (int jp = 0; jp < 2; ++jp) { u32x4 wv; wv.x = cvt_pk_bf16(p[2 * jp][0], p[2 * jp][1]); wv.y = cvt_pk_bf16(p[2 * jp][2], p[2 * jp][3]); \
                wv.z = cvt_pk_bf16(p[2 * jp + 1][0], p[2 * jp + 1][1]); wv.w = cvt_pk_bf16(p[2 * jp + 1][2], p[2 * jp + 1][3]); PB[mp][jp] = __builtin_bit_cast(bf16x8, wv); } } \
        if ((first) || __any(!(fmaxf(ps[0], ps[1]) < 512.0f))) { \
            _Pragma("unroll") for (int mp = 0; mp < 2; ++mp) { \
                float m_ = fmaxf(fmaxf(s[mp][0][0], s[mp][0][1]), fmaxf(s[mp][0][2], s[mp][0][3])); \
                _Pragma("unroll") for (int jt = 1; jt < 4; ++jt) m_ = fmaxf(fmaxf(m_, s[mp][jt][0]), fmaxf(fmaxf(s[mp][jt][1], s[mp][jt][2]), s[mp][jt][3])); \
                m_ = xrow16_max(m_); \
                const float delta = (first) ? m_ : fmaxf(m_, 0.f); \
                const float alpha = (first) ? 0.f : __builtin_amdgcn_exp2f(-delta); \
                negm[mp] -= delta; lsum[mp] *= alpha; \
                _Pragma("unroll") for (int vt = 0; vt < 8; ++vt) acc[mp][vt] *= alpha; \
                float a_ = 0.f; f32x4 p[4]; \
                _Pragma("unroll") for (int jt = 0; jt < 4; ++jt) _Pragma("unroll") for (int r = 0; r < 4; ++r) { p[jt][r] = __builtin_amdgcn_exp2f(s[mp][jt][r] - delta); a_ += p[jt][r]; } \
                ps[mp] = a_; \
                _Pragma("unroll") for (int jp = 0; jp < 2; ++jp) { u32x4 wv; wv.x = cvt_pk_bf16(p[2 * jp][0], p[2 * jp][1]); wv.y = cvt_pk_bf16(p[2 * jp][2], p[2 * jp][3]); \
                    wv.z = cvt_pk_bf16(p[2 * jp + 1][0], p[2 * jp + 1][1]); wv.w = cvt_pk_bf16(p[2 * jp + 1][2], p[2 * jp + 1][3]); PB[mp][jp] = __builtin_bit_cast(bf16x8, wv); } } \
        } \
        lsum[0] += ps[0]; lsum[1] += ps[1]; \
        _Pragma("unroll") for (int hb_ = 0; hb_ < 2; ++hb_) { bf16x8 vf_[8]; \
            _Pragma("unroll") for (int q_ = 0; q_ < 8; ++q_) { LAS const unsigned char* vp = vb_ + (q_ & 1) * (32 * 256) + (((hb_ * 4 + (q_ >> 1)) * 32) ^ gg32); vf_[q_] = ld_tr8(vp, vp + 16 * 256); } \
            __builtin_amdgcn_sched_barrier(0); \
            _Pragma("unroll") for (int q_ = 0; q_ < 8; ++q_) { acc[0][hb_ * 4 + (q_ >> 1)] = mfma16(vf_[q_], PB[0][q_ & 1], acc[0][hb_ * 4 + (q_ >> 1)]); acc[1][hb_ * 4 + (q_ >> 1)] = mfma16(vf_[q_], PB[1][q_ & 1], acc[1][hb_ * 4 + (q_ >> 1)]); } \
            __builtin_amdgcn_sched_barrier(0); } } while (0)
#define ATT_DMA2(t, KOFF, VOFF) do { const size_t to_ = (size_t)(t) * 8192; \
        _Pragma("unroll") for (int i_ = 0; i_ < 2; ++i_) { \
            __builtin_amdgcn_global_load_lds((const unsigned*)(kbase + to_ + ksrc[i_]), (LAS unsigned*)(lds + (KOFF) + (i_ * 8 + w) * 1024), 16, 0, 0); \
            __builtin_amdgcn_global_load_lds((const unsigned*)(vbase + to_ + vsrc[i_]), (LAS unsigned*)(lds + (VOFF) + (i_ * 8 + w) * 1024), 16, 0, 0); } } while (0)
    if (!staged) {
        __syncthreads();
        ATT_DMA2(0, 0, 16384);
        asm volatile("s_waitcnt vmcnt(0)" ::: "memory");
        __syncthreads();
    }
    const int nit = nkt >> 1;
    for (int it = 0; it < nit; ++it) {
        ATT_DMA2(2 * it + 1, 32768, 49152);
        ATT_TILE(0, 16384, it == 0);
        asm volatile("s_waitcnt vmcnt(0)" ::: "memory");
        __syncthreads();
        if (it + 1 < nit) ATT_DMA2(2 * it + 2, 0, 16384);
        else if (next_unit >= 0) {
#pragma unroll
            for (int i_ = 0; i_ < 2; ++i_) {
                __builtin_amdgcn_global_load_lds((const unsigned*)(nkbase + ksrc[i_]), (LAS unsigned*)(lds + 0 + (i_ * 8 + w) * 1024), 16, 0, 0);
                __builtin_amdgcn_global_load_lds((const unsigned*)(nvbase + vsrc[i_]), (LAS unsigned*)(lds + 16384 + (i_ * 8 + w) * 1024), 16, 0, 0); } }
        ATT_TILE(32768, 49152, false);
        asm volatile("s_waitcnt vmcnt(0)" ::: "memory");
        __syncthreads();
    }
#undef ATT_TILE
#undef ATT_DMA2
#undef ATT_DMA
#undef ATT_PV
    float l0 = lsum[0], l1 = lsum[1];
    l0 = xrow16_sum(l0); l1 = xrow16_sum(l1);
    const float i0 = 1.0f / l0, i1 = lam / l1;
    float ss = 0.f;
#pragma unroll
    for (int vt = 0; vt < 8; ++vt) { acc[0][vt] = acc[0][vt] * i0 - acc[1][vt] * i1; ss += (acc[0][vt][0] * acc[0][vt][0] + acc[0][vt][1] * acc[0][vt][1]) + (acc[0][vt][2] * acc[0][vt][2] + acc[0][vt][3] * acc[0][vt][3]); }
    ss = xrow16_sum(ss);
    const float rs = rsqrtf(ss * (1.0f / 128.0f) + EPS) * (1.0f - lam_init);
    const float* sub = A.in[16] + li * 128 + 4 * fq; const bf16_t* gp = Pn + Rq * 2048 + 1024 + h * 128 + 4 * fq; bf16_t* op = A2 + Rq * 1024 + h * 128 + 4 * fq;
#pragma unroll
    for (int vt = 0; vt < 8; ++vt) { const f32x4 sb = *(const f32x4*)(sub + 16 * vt); const u32x2 g = *(const u32x2*)(gp + 16 * vt);
        u32x2 wv; wv.x = cvt_pk_bf16(acc[0][vt][0] * rs * sb[0] * silu_f(bflo(g.x)), acc[0][vt][1] * rs * sb[1] * silu_f(bfhi(g.x)));
        wv.y = cvt_pk_bf16(acc[0][vt][2] * rs * sb[2] * silu_f(bflo(g.y)), acc[0][vt][3] * rs * sb[3] * silu_f(bfhi(g.y)));
        *(u32x2*)(op + 16 * vt) = wv; }
}

__device__ __forceinline__ void odd_mixer_phase(const Args& A, LAS unsigned char* lds, int l) {
    const int G = gridDim.x, bx = blockIdx.x, li = l >> 1;
    const float* lp = A.in[15] + li * 256; float d0 = 0.f, d1 = 0.f;
    for (int e = 0; e < 64; ++e) { d0 += lp[e] * lp[64 + e]; d1 += lp[128 + e] * lp[192 + e]; }
    const float lam_init = 0.8f - 0.6f * expf(-0.3f * (float)l);
    const float lam = expf(d0) - expf(d1) + lam_init;
    const int vcu = (G % 8 == 0) ? (bx % 8) * (G / 8) + bx / 8 : bx;
    const int nunits = (l == 3) ? 4096 : 4608;
    bool staged = false;
    for (int u = vcu; u < nunits; u += G) { const int nu = (u + G < nunits) ? u + G : -1; attn_unit(A, lds, u, nu, staged, l, lam, lam_init); staged = nu >= 0; }
}


#define XB_TMO      128
#define XB_XCNT(j)  (256  + 64 * (j))
#define XB_XSUB(j)  (1280 + 64 * (j))
#define XB_XGEN(j)  (2304 + 64 * (j))
#define XB_TOP      3328
#define XB_TOPGEN   3392
#define XCD_BAR_WORDS 3456
#define XB_SPIN_CAP (1u << 18)

__device__ __forceinline__ unsigned xb_ld(unsigned* p)              { return __hip_atomic_load(p, __ATOMIC_RELAXED, __HIP_MEMORY_SCOPE_AGENT); }
__device__ __forceinline__ unsigned xb_add(unsigned* p, unsigned v) { return __hip_atomic_fetch_add(p, v, __ATOMIC_RELAXED, __HIP_MEMORY_SCOPE_AGENT); }
__device__ __forceinline__ unsigned xb_xcc_id() { return (unsigned)__builtin_amdgcn_s_getreg((3 << 11) | 20) & 0xFu; }
#define XB_SPIN(cond, bar) do { unsigned _sp = 0; while (cond) { __builtin_amdgcn_s_sleep(1); \
    if ((++_sp & 255u) == 0u) { if (xb_ld(&(bar)[XB_TMO])) break; if (_sp > XB_SPIN_CAP) { atomicAdd(&(bar)[XB_TMO], 1u); break; } } } } while (0)

struct XcdBarrier {
    unsigned* bar; unsigned x;
    volatile LAS unsigned* st;
};

__device__ __forceinline__ XcdBarrier xcd_barrier_post(unsigned* bar, volatile LAS unsigned* st) {
    XcdBarrier b; b.bar = bar; b.x = xb_xcc_id(); b.st = st;
    if (threadIdx.x == 0) (void)xb_add(&bar[XB_XCNT(b.x)], 1u);
    return b;
}
__device__ __forceinline__ void xcd_barrier_complete(unsigned* bar, unsigned x, unsigned& nloc, unsigned& nx) {
    const unsigned G = gridDim.x * gridDim.y * gridDim.z;
    unsigned sum, cnt, mine, sp = 0u;
    for (;;) {
        sum = 0u; cnt = 0u; mine = 0u;
#pragma unroll
        for (unsigned j = 0; j < 16; ++j) { const unsigned c = xb_ld(&bar[XB_XCNT(j)]); sum += c; cnt += (c > 0u) ? 1u : 0u; mine = (j == x) ? c : mine; }
        if (sum == G) break;
        __builtin_amdgcn_s_sleep(1);
        if ((++sp & 255u) == 0u) { if (xb_ld(&bar[XB_TMO])) break; if (sp > XB_SPIN_CAP) { atomicAdd(&bar[XB_TMO], 1u); break; } }
    }
    nloc = mine > 0u ? mine : 1u; nx = cnt > 0u ? cnt : 1u;
}

__device__ __forceinline__ void xcd_barrier(const XcdBarrier& b) {
    asm volatile("s_waitcnt vmcnt(0)" ::: "memory");
    __syncthreads();
    if (threadIdx.x == 0) {
        unsigned* bar = b.bar;
        __builtin_amdgcn_s_waitcnt(0);
        unsigned nloc = b.st[0], nx = b.st[1];
        if (nloc == 0u) { xcd_barrier_complete(bar, b.x, nloc, nx); b.st[0] = nloc; b.st[1] = nx; }
        const unsigned old = xb_add(&bar[XB_XSUB(b.x)], 1u);
        const unsigned gen = old / nloc;
        if (old + 1u == (gen + 1u) * nloc) {
            __builtin_amdgcn_fence(__ATOMIC_RELEASE, "agent");
            asm volatile("s_waitcnt vmcnt(0)" ::: "memory");
            const unsigned og = xb_add(&bar[XB_TOP], 1u);
            const unsigned tg = og / nx;
            if (og + 1u == (tg + 1u) * nx) xb_add(&bar[XB_TOPGEN], 1u);
            else XB_SPIN(xb_ld(&bar[XB_TOPGEN]) == tg, bar);
            __builtin_amdgcn_fence(__ATOMIC_ACQUIRE, "agent");
            xb_add(&bar[XB_XGEN(b.x)], 1u);
            asm volatile("s_waitcnt vmcnt(0)" ::: "memory");
        } else {
            XB_SPIN(xb_ld(&bar[XB_XGEN(b.x)]) == gen, bar);
            __builtin_amdgcn_fence(__ATOMIC_ACQUIRE, "agent");
            asm volatile("s_waitcnt vmcnt(0)" ::: "memory");
        }
    }
    __syncthreads();
}


#ifdef NO_PRO
#define DIS_PRO(...)
#else
#define DIS_PRO(...) __VA_ARGS__
#endif
#ifdef NO_EW
#define DIS_EW(...)
#else
#define DIS_EW(...) __VA_ARGS__
#endif
#ifdef NO_EVEN
#define DIS_EVEN(...)
#else
#define DIS_EVEN(...) __VA_ARGS__
#endif
#ifdef NO_ODD
#define DIS_ODD(...)
#else
#define DIS_ODD(...) __VA_ARGS__
#endif
#ifdef NO_G1
#define DIS_G1(...)
#else
#define DIS_G1(...) __VA_ARGS__
#endif
#ifdef NO_G2
#define DIS_G2(...)
#else
#define DIS_G2(...) __VA_ARGS__
#endif
#ifdef NO_G3
#define DIS_G3(...)
#else
#define DIS_G3(...) __VA_ARGS__
#endif
template <bool EXTRA> struct TrimOrder : pg8::StaticOrder {
    __device__ void init2(int ncoltiles, int G_, int c_) { init(256 * 256, ncoltiles * 256, G_, c_); }
    __device__ bool next(int i, pg8::Unit& u) const {
        const long L = (long)i * G + c;
        if (L < nwg) { pg8::StaticOrder::next(i, u); u.pm = (u.pm >> 3) * 9 + (u.pm & 7) + 1; return true; }
        if (EXTRA) { const int L2 = (int)(L - nwg); if (L2 >= 256) return false; u.pm = 9 * (L2 >> 3); const int t = L2 & 7; u.pn = t < 4 ? 4 + t : 8 + t; return true; }
        return false;
    }
};
template <int PH> __device__ __forceinline__ void run_phase(const Args& A, LAS unsigned char* lds) {
    unsigned char* ws = A.ws;
    const int G = gridDim.x, bx = blockIdx.x;
    if constexpr (PH == 0) { DIS_PRO(prologue_phase(A, lds);) }
    else if constexpr (PH == 1) { DIS_EW(ew_phase(A, 0);) }
    else {
        constexpr int l = (PH - 2) >> 2, sub = (PH - 2) & 3, li = l >> 1;
        const bf16_t* H = (const bf16_t*)(ws + WS_H);
        if constexpr (sub == 0) {
            if constexpr ((l & 1) == 0) {
                const bf16_t* W = (const bf16_t*)(ws + WS_WTE) + (size_t)li * 3072 * 1024;
                pg8::Gemm g{H, W, NTOK, 3072, 1024}; pg8::StaticOrder S; S.init(NTOK, 3072, G, bx);
                EpiInNat<0> E{(bf16_t*)(ws + WS_P), 3072, (const f32x4*)(ws + WS_TABR), nullptr, nullptr};
                DIS_G1(pg8::gemm_phase<EpiInNat<0>, pg8::StaticOrder>(lds, g, S, E, nullptr);)
            } else {
                const bf16_t* W = (const bf16_t*)(ws + WS_WTO) + (size_t)li * 4096 * 1024;
                pg8::Gemm g{H, W, NTOK, 4096, 1024};
                EpiInNat<1> E{(bf16_t*)(ws + WS_P), 2048, (const f32x4*)(ws + WS_TABD), (bf16_t*)(ws + WS_OF), (bf16_t*)(ws + WS_T)};
                if constexpr (l == 3) { TrimOrder<true> S; S.init2(16, G, bx); DIS_G1(pg8::gemm_phase<EpiInNat<1>, TrimOrder<true>>(lds, g, S, E, nullptr);) }
                else { pg8::StaticOrder S; S.init(NTOK, 4096, G, bx); DIS_G1(pg8::gemm_phase<EpiInNat<1>, pg8::StaticOrder>(lds, g, S, E, nullptr);) }
            }
        } else if constexpr (sub == 1) {
            if constexpr ((l & 1) == 0) { DIS_EVEN(even_mixer_phase(A, lds, li);) } else { DIS_ODD(odd_mixer_phase(A, lds, l);) }
        } else if constexpr (sub == 2) {
            pg8::Gemm g{H, (const bf16_t*)(ws + WS_WOT) + (size_t)l * 1024 * 1024, NTOK, 1024, 1024};
            EpiY16 E{(bf16_t*)(ws + WS_P), 1024};
            if constexpr (l == 3) { TrimOrder<false> S; S.init2(4, G, bx); DIS_G3(pg8::gemm_phase<EpiY16, TrimOrder<false>>(lds, g, S, E, nullptr);) }
            else { pg8::StaticOrder S; S.init(NTOK, 1024, G, bx); DIS_G3(pg8::gemm_phase<EpiY16, pg8::StaticOrder>(lds, g, S, E, nullptr);) }
        } else { DIS_EW(ew_phase(A, l + 1);) }
    }
}
__global__ void __launch_bounds__(NTHREADS, 2) mk_fwd(Args A) {
    extern __shared__ __attribute__((aligned(16))) unsigned char lds_raw[];
    LAS unsigned char* lds = (LAS unsigned char*)lds_raw;
    cg::grid_group grid = cg::this_grid();
    volatile LAS unsigned* bst = (volatile LAS unsigned*)(lds + LDS_BYTES - 64);
    if (threadIdx.x < 2) bst[threadIdx.x] = 0u;
    __syncthreads();
    XcdBarrier xbar = xcd_barrier_post((unsigned*)(A.ws + WS_BAR), bst);
    int nsync = 0;
#ifndef REP_KIND
#define REP_KIND -1
#endif
#define KIND_OF(ph) ((ph) == 0 ? 4 : (ph) == 1 ? 9 : (((ph) - 2) & 3) == 0 ? 0 : (((ph) - 2) & 3) == 2 ? 3 : (((ph) - 2) & 3) == 3 ? 9 : (((((ph) - 2) >> 2) & 1) == 0 ? 1 : 2))
#define RUN(ph) if (A.ph_lo <= (ph) && (ph) < A.ph_hi) { run_phase<ph>(A, lds); if (KIND_OF(ph) == REP_KIND) { __syncthreads(); run_phase<ph>(A, lds); } if (KIND_OF(ph) == 1 && (REP_KIND == 5 || REP_KIND == 6)) { __syncthreads(); even_mixer_phase(A, lds, (((ph) - 2) >> 2) >> 1, REP_KIND - 4); } if ((ph) + 1 < A.ph_hi) { if (A.ph_hi > 1000) grid.sync(); else xcd_barrier(xbar); ++nsync;        if (REP_KIND == 7) { xcd_barrier(xbar); xcd_barrier(xbar); xcd_barrier(xbar); xcd_barrier(xbar); } } }
    RUN(0) RUN(1) RUN(2) RUN(3) RUN(4) RUN(5) RUN(6) RUN(7) RUN(8) RUN(9) RUN(10) RUN(11) RUN(12) RUN(13) RUN(14) RUN(15) RUN(16) RUN(17)
#undef RUN
}

#ifndef MK_MULTI
#define MK_MULTI 0
#endif
constexpr int NPHASES = 18;
extern "C" void kernel_launch(void* const* d_in, const int* in_sizes, int n_in, void* d_out, int out_size, void* d_ws, size_t ws_size, hipStream_t stream) {
    static int grid = 0;
    if (grid == 0) {
        if (n_in != 17 || ws_size < WS_END) { fprintf(stderr, "kernel_launch: unexpected inputs (n_in %d, ws %zu)\n", n_in, ws_size); grid = -1; return; }
        int dev = 0, cus = 0, per_cu = 0;
        hipGetDevice(&dev); hipDeviceGetAttribute(&cus, hipDeviceAttributeMultiprocessorCount, dev);
        if (hipFuncSetAttribute((const void*)mk_fwd, hipFuncAttributeMaxDynamicSharedMemorySize, LDS_BYTES) != hipSuccess) { fprintf(stderr, "kernel_launch: hipFuncSetAttribute failed\n"); grid = -1; return; }
        if (hipOccupancyMaxActiveBlocksPerMultiprocessor(&per_cu, (const void*)mk_fwd, NTHREADS, LDS_BYTES) != hipSuccess || per_cu < 1) { fprintf(stderr, "kernel_launch: occupancy query gave %d\n", per_cu); per_cu = 1; }
        (void)hipGetLastError();
        grid = cus * per_cu;
    }
    if (grid < 0) return;
    if (hipMemsetAsync((char*)d_ws + WS_BAR, 0, 16384, stream) != hipSuccess) { fprintf(stderr, "kernel_launch: memset failed\n"); return; }
    Args a{};
    for (int i = 0; i < 17; ++i) a.in[i] = (const float*)d_in[i];
    a.out = (float*)d_out; a.ws = (unsigned char*)d_ws;
#if MK_MULTI
    for (int ph = 0; ph < NPHASES; ++ph) { a.ph_lo = ph; a.ph_hi = ph + 1; hipLaunchKernelGGL(mk_fwd, dim3(grid), dim3(NTHREADS), LDS_BYTES, stream, a); }
#else
    a.ph_lo = 0; a.ph_hi = NPHASES;
    void* args[] = {&a};
    hipError_t e = hipLaunchCooperativeKernel((const void*)mk_fwd, dim3(grid), dim3(NTHREADS), args, LDS_BYTES, stream);
    if (e != hipSuccess) fprintf(stderr, "kernel_launch: cooperative launch failed: %s (grid %d)\n", hipGetErrorString(e), grid);
#endif
}
```

```cpp
#include <hip/hip_runtime.h>
#include <hip/hip_cooperative_groups.h>
#include <cstdio>
#include <cstdint>
namespace cg = cooperative_groups;
namespace pg8 {
#define PG8_LAS __attribute__((address_space(3)))
typedef unsigned short bf16_t;
typedef short bf16x8 __attribute__((ext_vector_type(8)));
typedef float f32x4 __attribute__((ext_vector_type(4)));
typedef unsigned u32x4 __attribute__((ext_vector_type(4)));
constexpr int BM = 256, BK = 64, HALF = 128, HTB = HALF * BK * 2  , STAGE_BYTES = 8 * HTB, NXCD = 8, WGM = 8;

__host__ __device__ __forceinline__ int lds_byte(int r, int c) { const int st = (r >> 4) * 2 + (c >> 5), rr = r & 15, cc = c & 31, ob = rr * 64 + cc * 2; return st * 1024 + (ob ^ (((ob >> 9) & 1) << 5)); }
__host__ __device__ __forceinline__ void stage_rc(int b, int& R, int& C) { const int st = b / 1024, sb = b % 1024, swz = sb ^ (((sb >> 9) & 1) << 5); R = (st >> 1) * 16 + swz / 64; C = (st & 1) * 32 + (swz % 64) / 2; }
__host__ __device__ __forceinline__ int perm32(int rho) { const int n = rho >> 4, i = rho & 15; return 8 * (i >> 2) + 4 * n + (i & 3); }

struct Unit { int pm, pn; };
struct Gemm { const bf16_t* A; const bf16_t* Bt; int M, N, K; };

struct StaticOrder {
    int nM, nN, nwg, G, c;
    __host__ __device__ void init(int M, int N, int G_, int c_) { nM = M / BM; nN = N / BM; nwg = nM * nN; G = G_; c = c_; }
    __host__ __device__ bool next(int i, Unit& u) const {
        const long L = (long)i * G + c; if (L >= nwg) return false;
        int wgid = (int)L; { const int q = nwg / NXCD, r = nwg % NXCD, xcd = wgid % NXCD, off = wgid / NXCD; wgid = (xcd < r ? xcd * (q + 1) : r * (q + 1) + (xcd - r) * q) + off; }
        const int nig = WGM * nN, gid = wgid / nig, fm = gid * WGM, gsz = (nM - fm) < WGM ? (nM - fm) : WGM;
        u.pm = fm + ((wgid % nig) % gsz); u.pn = (wgid % nig) / gsz; return true;
    }
    __device__ __forceinline__ void a_ready(const Unit&) const {}
    __device__ __forceinline__ void done(const Unit&) const {}
};
__device__ __forceinline__ unsigned cvt_pk_bf16(float lo, float hi) { unsigned r; asm volatile("v_cvt_pk_bf16_f32 %0, %1, %2" : "=v"(r) : "v"(lo), "v"(hi)); return r; }
typedef float f32x2 __attribute__((ext_vector_type(2)));
template <class Epi, class Sched, bool STAMP = false>
__device__ __forceinline__ void gemm_phase(PG8_LAS unsigned char* lds, const Gemm g, const Sched& S, const Epi& E, unsigned long long* stamps) {
    const int tid = threadIdx.x, wid = __builtin_amdgcn_readfirstlane(tid >> 6), lane = tid & 63, wr = wid >> 2, wc = wid & 3, fr = lane & 15, fq = lane >> 4;
    const int K = g.K, nt = K / BK;
    int ts_lo = 0, ts_hi = 0, nts = 0; const unsigned long long rt_entry = STAMP ? (unsigned long long)wall_clock64() : 0ull;
#define PG8_STAMP() do { if (STAMP && wid == 0 && nts < 64) { const unsigned long long _c = (unsigned long long)clock64(); \
        ts_lo = (lane == nts) ? (int)(unsigned)_c : ts_lo; ts_hi = (lane == nts) ? (int)(unsigned)(_c >> 32) : ts_hi; ++nts; } } while (0)
    PG8_STAMP();
    unsigned voffA[2], voffB[2];
#pragma unroll
    for (int i = 0; i < 2; ++i) { int R, C; stage_rc(tid * 16 + i * 8192, R, C); const int Rb = Epi::PERM ? ((R & ~31) + perm32(R & 31)) : R;
        voffA[i] = (unsigned)(R * K + C) * 2u; voffB[i] = (unsigned)(Rb * K + C) * 2u; }
    const size_t kstep = (size_t)(BK * 2);
    const size_t hstep = (size_t)HALF * K * 2;
    const size_t tstep = 2 * hstep;
    const unsigned ldsw = (unsigned)wid * 1024u;
    const int aoff = lds_byte(wr * 64 + fr, fq * 8), boff = lds_byte(wc * 32 + fr, fq * 8);
#define PG8_SA(b, h) (((b) * 2 + (h)) * HTB)
#define PG8_SB(b, h) ((4 + (b) * 2 + (h)) * HTB)
#define PG8_STAGE(bufoff, gbase, voff) do { _Pragma("unroll") for (int _i = 0; _i < 2; ++_i) \
        __builtin_amdgcn_global_load_lds((const unsigned*)((const char*)(gbase) + (voff)[_i]), (PG8_LAS unsigned*)(lds + (bufoff) + ldsw + _i * 8192), 16, 0, 0); } while (0)
#define PG8_LDA(dst, b, h) do { _Pragma("unroll") for (int m = 0; m < 4; ++m) _Pragma("unroll") for (int k = 0; k < 2; ++k) dst[m][k] = *(const PG8_LAS bf16x8*)(lds + PG8_SA(b, h) + aoff + m * 2048 + k * 1024); } while (0)
#define PG8_LDB(dst, b, h) do { _Pragma("unroll") for (int n = 0; n < 2; ++n) _Pragma("unroll") for (int k = 0; k < 2; ++k) dst[n][k] = *(const PG8_LAS bf16x8*)(lds + PG8_SB(b, h) + boff + n * 2048 + k * 1024); } while (0)
#define PG8_MMA(ai, bj, At, Bt) do { __builtin_amdgcn_s_setprio(1); _Pragma("unroll") for (int m = 0; m < 4; ++m) _Pragma("unroll") for (int n = 0; n < 2; ++n) _Pragma("unroll") for (int k = 0; k < 2; ++k) \
        acc[ai][bj][m][n] = __builtin_amdgcn_mfma_f32_16x16x32_bf16(Bt[n][k], At[m][k], acc[ai][bj][m][n], 0, 0, 0); __builtin_amdgcn_s_setprio(0); } while (0)
#define PG8_WAIT_V(n) asm volatile("s_waitcnt vmcnt(" #n ")" ::: "memory")
#define PG8_WAIT_L(n) asm volatile("s_waitcnt lgkmcnt(" #n ")" ::: "memory")
#define PG8_BAR __builtin_amdgcn_s_barrier()
#define PG8_SCHED __builtin_amdgcn_sched_barrier(0)
    Unit cur, nxt; int ui = 0;
    if (!S.next(0, cur)) return;
    f32x4 acc[2][2][4][2];
#pragma unroll
    for (int a = 0; a < 2; ++a)
#pragma unroll
        for (int b = 0; b < 2; ++b)
#pragma unroll
            for (int m = 0; m < 4; ++m)
#pragma unroll
                for (int n = 0; n < 2; ++n) acc[a][b][m][n] = (f32x4){0.f, 0.f, 0.f, 0.f};
    bf16x8 At[4][2], B0[2][2], B1[2][2];
    const char* cA = (const char*)g.A + (size_t)cur.pm * tstep; const char* cB = (const char*)g.Bt + (size_t)cur.pn * tstep;
    S.a_ready(cur);
    PG8_STAGE(PG8_SB(0, 0), cB, voffB); PG8_STAGE(PG8_SA(0, 0), cA, voffA); PG8_STAGE(PG8_SB(0, 1), cB + hstep, voffB); PG8_STAGE(PG8_SA(0, 1), cA + hstep, voffA);
    if (wr == 1) PG8_BAR;
    PG8_WAIT_V(4); PG8_BAR;
    PG8_STAGE(PG8_SB(1, 0), cB + kstep, voffB); PG8_STAGE(PG8_SA(1, 0), cA + kstep, voffA); PG8_STAGE(PG8_SB(1, 1), cB + hstep + kstep, voffB);
    PG8_WAIT_V(6); PG8_BAR;
    PG8_STAMP();
    for (;;) {
        const bool has_next = S.next(ui + 1, nxt);
        const char* nA = has_next ? (const char*)g.A + (size_t)nxt.pm * tstep : cA; const char* nB = has_next ? (const char*)g.Bt + (size_t)nxt.pn * tstep : cB;
        for (int t = 0; t < nt; t += 2) {
            const bool last = (t == nt - 2);
            const char* a1 = cA + (size_t)(t + 1) * kstep;
            const char* a2 = last ? nA : cA + (size_t)(t + 2) * kstep; const char* b2 = last ? nB : cB + (size_t)(t + 2) * kstep;
            const char* a3 = a2 + kstep; const char* b3 = b2 + kstep;
            if (last && has_next) S.a_ready(nxt);
            PG8_LDB(B0, 0, 0); PG8_SCHED; PG8_LDA(At, 0, 0); PG8_STAGE(PG8_SA(1, 1), a1 + hstep, voffA);
            PG8_WAIT_L(8); PG8_BAR; PG8_WAIT_L(0); PG8_MMA(0, 0, At, B0); PG8_BAR; PG8_SCHED;
            PG8_LDB(B1, 0, 1); PG8_STAGE(PG8_SB(0, 0), b2, voffB);
            PG8_BAR; PG8_WAIT_L(0); PG8_MMA(0, 1, At, B1); PG8_BAR;
            PG8_LDA(At, 0, 1); PG8_STAGE(PG8_SA(0, 0), a2, voffA);
            PG8_BAR; PG8_WAIT_L(0); PG8_MMA(1, 0, At, B0); PG8_BAR; PG8_SCHED;
            PG8_STAGE(PG8_SB(0, 1), b2 + hstep, voffB);
            PG8_WAIT_V(6); PG8_BAR; PG8_MMA(1, 1, At, B1); PG8_BAR;
            PG8_LDB(B0, 1, 0); PG8_SCHED; PG8_LDA(At, 1, 0); PG8_STAGE(PG8_SA(0, 1), a2 + hstep, voffA);
            PG8_WAIT_L(8); PG8_BAR; PG8_WAIT_L(0); PG8_MMA(0, 0, At, B0); PG8_BAR; PG8_SCHED;
            PG8_LDB(B1, 1, 1); PG8_STAGE(PG8_SB(1, 0), b3, voffB);
            PG8_BAR; PG8_WAIT_L(0); PG8_MMA(0, 1, At, B1); PG8_BAR;
            PG8_LDA(At, 1, 1); PG8_STAGE(PG8_SA(1, 0), a3, voffA);
            PG8_BAR; PG8_WAIT_L(0); PG8_MMA(1, 0, At, B0); PG8_BAR; PG8_SCHED;
            PG8_STAGE(PG8_SB(1, 1), b3 + hstep, voffB);
            PG8_WAIT_V(6); PG8_BAR; PG8_MMA(1, 1, At, B1); PG8_BAR;
        }
        PG8_STAMP();
        if constexpr (!Epi::AFTER_DRAIN) { E(acc, cur, wr, wc, fr, fq); S.done(cur); }
        PG8_STAMP();
        if (!has_next) break;
#pragma unroll
        for (int a = 0; a < 2; ++a)
#pragma unroll
            for (int b = 0; b < 2; ++b)
#pragma unroll
                for (int m = 0; m < 4; ++m)
#pragma unroll
                    for (int n = 0; n < 2; ++n) acc[a][b][m][n] = (f32x4){0.f, 0.f, 0.f, 0.f};
        cur = nxt; cA = nA; cB = nB; ++ui;
    }
    PG8_WAIT_V(0);
    if (wr == 0) PG8_BAR;
    PG8_BAR;
    if constexpr (Epi::AFTER_DRAIN) { E.fused(acc, cur, wr, wc, fr, fq, lds, wid, lane); S.done(cur); }
    PG8_STAMP();
    if (STAMP && wid == 0) { stamps[lane] = lane < nts ? (((unsigned long long)(unsigned)ts_hi << 32) | (unsigned)ts_lo) : 0ull;
        if (lane == 62) stamps[62] = rt_entry; if (lane == 63) stamps[63] = (unsigned long long)wall_clock64(); }
#undef PG8_STAMP
#undef PG8_SA
#undef PG8_SB
#undef PG8_STAGE
#undef PG8_LDA
#undef PG8_LDB
#undef PG8_MMA
#undef PG8_WAIT_V
#undef PG8_WAIT_L
#undef PG8_BAR
#undef PG8_SCHED
}
}

#define LAS __attribute__((address_space(3)))
using pg8::bf16_t; using pg8::bf16x8; using pg8::f32x4; using pg8::u32x4; using pg8::cvt_pk_bf16;
typedef unsigned u32x2 __attribute__((ext_vector_type(2)));
typedef float f32x2v __attribute__((ext_vector_type(2)));

constexpr int D = 1024, NB = 32, SEQ = 2048, CTXL = 256, SROW = 2304, NTOK = NB * SROW;
constexpr float EPS = 1e-6f;
constexpr int NTHREADS = 512;
constexpr int LDS_BYTES = 147456;
constexpr size_t MiB = 1u << 20;
constexpr size_t WS_BAR = 0;
constexpr size_t WS_MOD = 1 * MiB;
constexpr size_t WS_TABR = 3 * MiB;
constexpr size_t WS_TABRT = WS_TABR + 65536;
constexpr size_t WS_TABD = WS_TABRT + 65536;
constexpr size_t WS_WTE = 4 * MiB;
constexpr size_t WS_WTO = 16 * MiB;
constexpr size_t WS_WOT = 32 * MiB;
constexpr size_t WS_PWT = 40 * MiB;
constexpr size_t WS_XC = 48 * MiB;
constexpr size_t WS_H = 80 * MiB;
constexpr size_t WS_P = 224 * MiB;
constexpr size_t WS_T = 656 * MiB;
constexpr size_t WS_OF = 800 * MiB;
constexpr size_t WS_END = 944 * MiB;

struct Args { const float* in[17]; float* out; unsigned char* ws; int ph_lo, ph_hi; };

__device__ __forceinline__ float bf2f(unsigned short u) { return __uint_as_float(((unsigned)u) << 16); }
__device__ __forceinline__ float bflo(unsigned w) { return __uint_as_float(w << 16); }
__device__ __forceinline__ float bfhi(unsigned w) { return __uint_as_float(w & 0xffff0000u); }
__device__ __forceinline__ float silu_f(float x) { return x * __builtin_amdgcn_rcpf(1.0f + __expf(-x)); }
__device__ __forceinline__ f32x4 mfma16(bf16x8 a, bf16x8 b, f32x4 c) { return __builtin_amdgcn_mfma_f32_16x16x32_bf16(a, b, c, 0, 0, 0); }
template <int CTRL> __device__ __forceinline__ float dpp_f(float x) { return __builtin_bit_cast(float, __builtin_amdgcn_mov_dpp(__builtin_bit_cast(int, x), CTRL, 0xf, 0xf, true)); }
__device__ __forceinline__ float wave_sum(float v) {
    v += dpp_f<0xB1>(v);
    v += dpp_f<0x4E>(v);
    v += dpp_f<0x124>(v);
    v += dpp_f<0x128>(v);
    auto s = __builtin_amdgcn_permlane16_swap(__float_as_uint(v), __float_as_uint(v), false, false);
    v = __uint_as_float(s[0]) + __uint_as_float(s[1]);
    auto t = __builtin_amdgcn_permlane32_swap(__float_as_uint(v), __float_as_uint(v), false, false);
    return __uint_as_float(t[0]) + __uint_as_float(t[1]);
}

__device__ __forceinline__ float xrow16_max(float x) {
    auto s = __builtin_amdgcn_permlane16_swap(__float_as_uint(x), __float_as_uint(x), false, false);
    x = fmaxf(__uint_as_float(s[0]), __uint_as_float(s[1]));
    auto t = __builtin_amdgcn_permlane32_swap(__float_as_uint(x), __float_as_uint(x), false, false);
    return fmaxf(__uint_as_float(t[0]), __uint_as_float(t[1]));
}
__device__ __forceinline__ float xrow16_sum(float x) {
    auto s = __builtin_amdgcn_permlane16_swap(__float_as_uint(x), __float_as_uint(x), false, false);
    x = __uint_as_float(s[0]) + __uint_as_float(s[1]);
    auto t = __builtin_amdgcn_permlane32_swap(__float_as_uint(x), __float_as_uint(x), false, false);
    return __uint_as_float(t[0]) + __uint_as_float(t[1]);
}
typedef short s16x4 __attribute__((ext_vector_type(4)));
__device__ __forceinline__ bf16x8 ld_tr8(LAS const unsigned char* p0, LAS const unsigned char* p1) {
    const s16x4 a = __builtin_amdgcn_ds_read_tr16_b64_v4i16((LAS s16x4*)p0), b = __builtin_amdgcn_ds_read_tr16_b64_v4i16((LAS s16x4*)p1);
    return (bf16x8){a[0], a[1], a[2], a[3], b[0], b[1], b[2], b[3]};
}
template <int odd> struct EpiInNat {
    static constexpr bool PERM = true, AFTER_DRAIN = false;
    bf16_t* O; int ldc; const f32x4* tab; bf16_t* KB; bf16_t* VB;
    __device__ __forceinline__ void operator()(const f32x4 (&acc)[2][2][4][2], const pg8::Unit& u, int wr, int wc, int fr, int fq) const {
        const int pn = u.pn;
        const bool latent = (u.pm % 9) != 0;
        bool rope; float scl = 1.0f; int ax, i0, nf;
        if (odd) { rope = latent && pn < 8; ax = wc & 1; i0 = 4 * fq; nf = 16; }
        else { rope = latent && (pn < 2 || pn == 8 || pn == 9); ax = wc >> 1; i0 = 16 * (wc & 1) + 4 * fq; nf = 32; if (pn == 8 || pn == 9) scl = 0.08838834764831845f; }
        float frv[4];
#pragma unroll
        for (int e = 0; e < 4; ++e) frv[e] = exp2f(-(float)(2 * (i0 + e)) * (13.287712379549449f / (float)(2 * nf))) * 0.15915494309189535f;
        const int srow0 = (u.pm % 9) * 256 + wr * 64 + fr;
        const size_t row0 = (size_t)u.pm * 256 + wr * 64 + fr; const int col0 = pn * 256 + wc * 32 + 8 * fq;
        const bool ksec = odd && ((pn >= 4 && pn < 8) || pn >= 12);
        bf16_t* kb0 = (pn >= 12 ? VB : KB) + ((size_t)((u.pm / 9) * 8 + ((pn - 4) & 7) * 2) * SROW) * 128 + wc * 32 + 8 * fq;
        const int colw = (odd && pn >= 8) ? col0 - 1024 : col0;
        const size_t bjs = ksec ? (size_t)SROW * 128 : 128;
#pragma unroll
        for (int ai = 0; ai < 2; ++ai)
#pragma unroll
            for (int m = 0; m < 4; ++m) {
                f32x4 cs0 = {1.f, 0.f, 1.f, 0.f}, cs1 = {1.f, 0.f, 1.f, 0.f};
                if (rope) { const int t = srow0 + ai * 128 + m * 16 - 256; const float pos = (float)(ax ? (t & 63) : (t >> 6));
                    const float r0 = __builtin_amdgcn_fractf(pos * frv[0]), r1 = __builtin_amdgcn_fractf(pos * frv[1]), r2 = __builtin_amdgcn_fractf(pos * frv[2]), r3 = __builtin_amdgcn_fractf(pos * frv[3]);
                    cs0 = (f32x4){__builtin_amdgcn_cosf(r0), __builtin_amdgcn_sinf(r0), __builtin_amdgcn_cosf(r1), __builtin_amdgcn_sinf(r1)};
                    cs1 = (f32x4){__builtin_amdgcn_cosf(r2), __builtin_amdgcn_sinf(r2), __builtin_amdgcn_cosf(r3), __builtin_amdgcn_sinf(r3)}; }
                bf16_t* rowp = ksec ? kb0 + (size_t)(srow0 + ai * 128 + m * 16) * 128 : O + (row0 + ai * 128 + m * 16) * (size_t)ldc + colw;
#pragma unroll
                for (int bj = 0; bj < 2; ++bj) {
                    const f32x4 v0 = acc[ai][bj][m][0], v1 = acc[ai][bj][m][1];
                    const float a0 = (v0[0] * cs0[0] - v0[1] * cs0[1]) * scl, a1 = (v0[0] * cs0[1] + v0[1] * cs0[0]) * scl;
                    const float a2 = (v0[2] * cs0[2] - v0[3] * cs0[3]) * scl, a3 = (v0[2] * cs0[3] + v0[3] * cs0[2]) * scl;
                    const float b0 = (v1[0] * cs1[0] - v1[1] * cs1[1]) * scl, b1 = (v1[0] * cs1[1] + v1[1] * cs1[0]) * scl;
                    const float b2 = (v1[2] * cs1[2] - v1[3] * cs1[3]) * scl, b3 = (v1[2] * cs1[3] + v1[3] * cs1[2]) * scl;
                    u32x4 w; w.x = cvt_pk_bf16(a0, a1); w.y = cvt_pk_bf16(a2, a3); w.z = cvt_pk_bf16(b0, b1); w.w = cvt_pk_bf16(b2, b3);
                    *(u32x4*)(rowp + bj * bjs) = w;
                }
            }
    }
};
struct EpiY16 {
    static constexpr bool PERM = true, AFTER_DRAIN = false;
    bf16_t* C; int ldc;
    __device__ __forceinline__ void operator()(const f32x4 (&acc)[2][2][4][2], const pg8::Unit& u, int wr, int wc, int fr, int fq) const {
        const size_t row0 = (size_t)u.pm * 256 + wr * 64 + fr; const int col0 = u.pn * 256 + wc * 32 + 8 * fq;
#pragma unroll
        for (int ai = 0; ai < 2; ++ai)
#pragma unroll
            for (int m = 0; m < 4; ++m) { bf16_t* rowp = C + (row0 + ai * 128 + m * 16) * (size_t)ldc + col0;
#pragma unroll
                for (int bj = 0; bj < 2; ++bj) { const f32x4 v0 = acc[ai][bj][m][0], v1 = acc[ai][bj][m][1];
                    u32x4 w; w.x = cvt_pk_bf16(v0[0], v0[1]); w.y = cvt_pk_bf16(v0[2], v0[3]); w.z = cvt_pk_bf16(v1[0], v1[1]); w.w = cvt_pk_bf16(v1[2], v1[3]);
                    *(u32x4*)(rowp + bj * 128) = w; } }
    }
};

__device__ __forceinline__ int src_col(int mode, int n) {
    if (mode == 0) {
        const int sec = n >> 9, within = n & 511;
        const int base = (sec == 0) ? 0 : (sec == 1) ? 1536 : (sec == 2) ? 2048 : (sec == 3) ? 2560 : (sec == 4) ? 512 : 1024;
        if (sec == 0 || sec == 4) { const int head = within >> 7, np = within & 127, pp = np >> 1, which = np & 1, a = pp >> 5, i = pp & 31; return base + head * 128 + 64 * a + 32 * which + i; }
        return base + within;
    } else if (mode == 1) {
        const int sec = n >> 10, within = n & 1023;
        const int base = (sec == 0) ? 0 : (sec == 1) ? 1024 : (sec == 2) ? 3072 : 2048;
        if (sec < 2) { const int grp = within >> 6, np = within & 63, pp = np >> 1, which = np & 1, a = pp >> 4, i = pp & 15; return base + grp * 64 + 32 * a + 16 * which + i; }
        return base + within;
    }
    return n;
}
__device__ __forceinline__ void conv_w(bf16_t* dst, const float* src, int nrows, int K, int ld, int mode, int gtid, int gthreads) {
    const int items = nrows * (K >> 3);
    for (int it = gtid; it < items; it += gthreads) {
        const int n = it % nrows, k8 = it / nrows;
        const float* s = src + (size_t)(k8 * 8) * ld + src_col(mode, n);
        float v[8];
#pragma unroll
        for (int e = 0; e < 8; ++e) v[e] = s[(size_t)e * ld];
        u32x4 w; w.x = cvt_pk_bf16(v[0], v[1]); w.y = cvt_pk_bf16(v[2], v[3]); w.z = cvt_pk_bf16(v[4], v[5]); w.w = cvt_pk_bf16(v[6], v[7]);
        *(u32x4*)(dst + (size_t)n * K + k8 * 8) = w;
    }
}

__device__ __forceinline__ void prologue_phase(const Args& A, LAS unsigned char* lds) {
    const int tid = threadIdx.x, lane = tid & 63, wave = tid >> 6, G = gridDim.x, bx = blockIdx.x;
    unsigned char* ws = A.ws;
    float* MOD = (float*)(ws + WS_MOD);
    for (int u = bx; u < 192; u += G) {
        const int l = u / 48, n0 = (u % 48) * 64;
        LAS float* sl = (LAS float*)lds;
        for (int idx = tid; idx < 33 * 1024; idx += NTHREADS) { const int v = idx >> 10, k = idx & 1023; const float x = (v < 32) ? A.in[1][v * 1024 + k] : A.in[3][k]; sl[idx] = silu_f(x); }
        __syncthreads();
        float acc[33];
#pragma unroll
        for (int v = 0; v < 33; ++v) acc[v] = 0.f;
        const float* w = A.in[4] + ((size_t)l * 1024 + wave * 128) * 3072 + n0 + lane;
        for (int kk = 0; kk < 128; ++kk) { const float wv = w[(size_t)kk * 3072]; const int k = wave * 128 + kk;
#pragma unroll
            for (int v = 0; v < 33; ++v) acc[v] += sl[v * 1024 + k] * wv; }
        __syncthreads();
#pragma unroll
        for (int v = 0; v < 33; ++v) sl[(wave * 33 + v) * 64 + lane] = acc[v];
        __syncthreads();
        for (int idx = tid; idx < 33 * 64; idx += NTHREADS) { const int v = idx >> 6, ln = idx & 63; float s = 0.f;
#pragma unroll
            for (int w8 = 0; w8 < 8; ++w8) s += sl[(w8 * 33 + v) * 64 + ln];
            MOD[(size_t)(l * 33 + v) * 3072 + n0 + ln] = s + A.in[5][l * 3072 + n0 + ln]; }
        __syncthreads();
    }
    const int gtid = bx * NTHREADS + tid, gthreads = G * NTHREADS;
    for (int it = gtid; it < 3072; it += gthreads) {
        if (it < 2048) { const int pos = it >> 5, i = it & 31; const float fr = exp2f(-(float)(2 * i) * (13.287712379549449f / 64.0f)); const float ang = (float)pos * fr;
            const float c = cosf(ang), s = sinf(ang);
            float* t1 = (float*)(ws + WS_TABR) + 2 * (pos * 32 + i); t1[0] = c; t1[1] = s;
            float* t2 = (float*)(ws + WS_TABRT) + 2 * (i * 64 + pos); t2[0] = c; t2[1] = s; }
        else { const int j = it - 2048, pos = j >> 4, i = j & 15; const float fr = exp2f(-(float)(2 * i) * (13.287712379549449f / 32.0f)); const float ang = (float)pos * fr;
            float* t1 = (float*)(ws + WS_TABD) + 2 * (pos * 16 + i); t1[0] = cosf(ang); t1[1] = sinf(ang); }
    }
    for (int i = 0; i < 2; ++i) {
        conv_w((bf16_t*)(ws + WS_WTE) + (size_t)i * 3072 * 1024, A.in[8] + (size_t)i * 1024 * 3072, 3072, 1024, 3072, 0, gtid, gthreads);
        conv_w((bf16_t*)(ws + WS_WTO) + (size_t)i * 4096 * 1024, A.in[13] + (size_t)i * 1024 * 4096, 4096, 1024, 4096, 1, gtid, gthreads);
        conv_w((bf16_t*)(ws + WS_WOT) + (size_t)(2 * i) * 1024 * 1024, A.in[9] + (size_t)i * 1024 * 1024, 1024, 1024, 1024, 2, gtid, gthreads);
        conv_w((bf16_t*)(ws + WS_WOT) + (size_t)(2 * i + 1) * 1024 * 1024, A.in[14] + (size_t)i * 1024 * 1024, 1024, 1024, 1024, 2, gtid, gthreads);
    }
    for (int m = 0; m < 8; ++m) conv_w((bf16_t*)(ws + WS_PWT) + m * 16384, A.in[11] + m * 16384, 128, 128, 128, 2, gtid, gthreads);
}

__device__ __forceinline__ void ew_phase(const Args& A, int l) {
    const int tid = threadIdx.x, lane = tid & 63, wave = tid >> 6;
    unsigned char* ws = A.ws;
    const float* MOD = (const float*)(ws + WS_MOD); const bf16_t* Y = (const bf16_t*)(ws + WS_P); bf16_t* H = (bf16_t*)(ws + WS_H); float* XC = (float*)(ws + WS_XC);
    const int nw = gridDim.x * 8;
    constexpr int NR = 4;
    for (int Ra = (blockIdx.x * 8 + wave) * NR; Ra < NTOK; Ra += NR * nw) {
        if (l == 4 && (Ra % SROW) < CTXL) continue;
        int Rr[NR]; bool act[NR]; const float* xin[NR]; float* xout[NR]; int vv[NR];
#pragma unroll
        for (int q = 0; q < NR; ++q) Rr[q] = Ra + q;
#pragma unroll
        for (int q = 0; q < NR; ++q) {
            const int R = Rr[q] < NTOK ? Rr[q] : Ra; const int b = R / SROW, s = R - b * SROW; const bool isctx = s < CTXL;
            act[q] = (Rr[q] < NTOK) && !(l == 4 && isctx); Rr[q] = R; vv[q] = isctx ? 32 : b;
            if (isctx) { const size_t o = ((size_t)b * CTXL + s) * D; xout[q] = XC + o; xin[q] = (l <= 1) ? A.in[2] + o : xout[q]; }
            else { const size_t o = ((size_t)b * SEQ + (s - CTXL)) * D; xout[q] = A.out + o; xin[q] = (l <= 1) ? A.in[0] + o : xout[q]; }
        }
        f32x4 xv[NR][4]; u32x2 yr[NR][4];
#pragma unroll
        for (int q = 0; q < NR; ++q)
#pragma unroll
            for (int k = 0; k < 4; ++k) { xv[q][k] = __builtin_nontemporal_load((const f32x4*)(xin[q] + 4 * lane + 256 * k)); if (l > 0) yr[q][k] = __builtin_nontemporal_load((const u32x2*)(Y + (size_t)Rr[q] * D + 4 * lane + 256 * k)); }
#pragma unroll
        for (int q = 0; q < NR; ++q) {
            if (l > 0) {
                f32x4 yv[4]; float ss = 0.f;
#pragma unroll
                for (int k = 0; k < 4; ++k) { yv[k] = (f32x4){bflo(yr[q][k].x), bfhi(yr[q][k].x), bflo(yr[q][k].y), bfhi(yr[q][k].y)}; ss += yv[k][0] * yv[k][0] + yv[k][1] * yv[k][1] + yv[k][2] * yv[k][2] + yv[k][3] * yv[k][3]; }
                ss = wave_sum(ss); const float r = rsqrtf(ss * (1.0f / D) + EPS);
                const float* gate = MOD + (size_t)((l - 1) * 33 + vv[q]) * 3072 + 2048; const float* np = A.in[7] + (l - 1) * D;
#pragma unroll
                for (int k = 0; k < 4; ++k) { const f32x4 g = *(const f32x4*)(gate + 4 * lane + 256 * k), n = *(const f32x4*)(np + 4 * lane + 256 * k);
                    xv[q][k] += g * (yv[k] * r * n); if (act[q] && !(l == 3 && vv[q] == 32)) __builtin_nontemporal_store(xv[q][k], (f32x4*)(xout[q] + 4 * lane + 256 * k)); }
            }
            if (l < 4) {
                float ss = 0.f;
#pragma unroll
                for (int k = 0; k < 4; ++k) ss += xv[q][k][0] * xv[q][k][0] + xv[q][k][1] * xv[q][k][1] + xv[q][k][2] * xv[q][k][2] + xv[q][k][3] * xv[q][k][3];
                ss = wave_sum(ss); const float r = rsqrtf(ss * (1.0f / D) + EPS);
                const float* md = MOD + (size_t)(l * 33 + vv[q]) * 3072; const float* np = A.in[6] + l * D;
#pragma unroll
                for (int k = 0; k < 4; ++k) { const f32x4 sh = *(const f32x4*)(md + 4 * lane + 256 * k), sc = *(const f32x4*)(md + 1024 + 4 * lane + 256 * k), n = *(const f32x4*)(np + 4 * lane + 256 * k);
                    const f32x4 h = xv[q][k] * r * n * (sc + 1.0f) + sh;
                    u32x2 w; w.x = cvt_pk_bf16(h[0], h[1]); w.y = cvt_pk_bf16(h[2], h[3]);
                    if (act[q]) *(u32x2*)(H + (size_t)Rr[q] * D + 4 * lane + 256 * k) = w; }
            }
        }
    }
}

constexpr int RP = 288;
__device__ __forceinline__ bf16x8 ld_frag16(LAS const unsigned char* p) { return *(LAS const bf16x8*)p; }
__device__ __forceinline__ bf16x8 ld_frag8x2(LAS const unsigned char* p0, LAS const unsigned char* p1) {
    const u32x2 a = *(LAS const u32x2*)p0, b = *(LAS const u32x2*)p1; u32x4 w; w.x = a.x; w.y = a.y; w.z = b.x; w.w = b.y; return __builtin_bit_cast(bf16x8, w); }

__device__ __forceinline__ void stage128(LAS unsigned char* dst, const bf16_t* src, size_t gp, int tid) {
    u32x4 r[4];
#pragma unroll
    for (int k = 0; k < 4; ++k) { const int q = tid + NTHREADS * k, row = q >> 4, cc = q & 15; r[k] = *(const u32x4*)(src + (size_t)row * gp + cc * 8); }
#pragma unroll
    for (int k = 0; k < 4; ++k) { const int q = tid + NTHREADS * k, row = q >> 4, cc = q & 15; *(LAS u32x4*)(dst + row * RP + cc * 16) = r[k]; }
}

__device__ __forceinline__ void retention_unit(const Args& A, LAS unsigned char* lds, int unit, int li  ) {
    const int tid = threadIdx.x, lane = tid & 63, w = __builtin_amdgcn_readfirstlane(tid >> 6), fr = lane & 15, fq = lane >> 4;
    const int b = unit >> 2, h = unit & 3;
    unsigned char* ws = A.ws;
    const bf16_t* Pn = (const bf16_t*)(ws + WS_P); float* OF = (float*)(ws + WS_OF); bf16_t* A2 = (bf16_t*)(ws + WS_H);
    LAS unsigned char* Ks = lds; LAS unsigned char* Vs = lds + 128 * RP; LAS unsigned char* Ss = lds + 2 * 128 * RP;
    const int trq = 4 * fq + (fr >> 2), trp = 8 * (fr & 3);
    LAS float* KD = (LAS float*)(lds + 3 * 128 * RP); LAS float* DT = KD + 128;
    { const float l2f_ = -__expf(A.in[10][(li * 2 + 0) * 4 + h]) * 1.4426950408889634f, l2b_ = -__expf(A.in[10][(li * 2 + 1) * 4 + h]) * 1.4426950408889634f;
      __syncthreads();
      for (int e = tid; e < 4 * 264; e += NTHREADS) { const int a = e / 264, m = e - a * 264 + a, dl = 127 - m;
          DT[e] = (dl >= 0) ? exp2f(l2f_ * (float)dl) : exp2f(-l2b_ * (float)dl); } }

    const int iloc = 16 * w + fr;
    LAS const float* dtp = DT + ((127 - iloc) & 3) * 264 + ((127 - iloc) & ~3) + 4 * fq;
#pragma unroll 1
    for (int dir = 0; dir < 2; ++dir) {
        const float l2 = -__expf(A.in[10][(li * 2 + dir) * 4 + h]) * 1.4426950408889634f;
        const float cdec = exp2f(l2 * 128.0f);
        const float qd = exp2f(l2 * (dir == 0 ? (float)(iloc + 1) : (float)(128 - iloc)));
        f32x4 accS[8];
#pragma unroll
        for (int dt = 0; dt < 8; ++dt) accS[dt] = (f32x4){0.f, 0.f, 0.f, 0.f};
        __syncthreads();
        if (tid < 128) KD[tid] = exp2f(l2 * (dir == 0 ? (float)(127 - tid) : (float)tid));
        for (int q = tid; q < 128 * 16; q += NTHREADS) *(LAS u32x4*)(Ss + (q >> 4) * RP + (q & 15) * 16) = (u32x4){0u, 0u, 0u, 0u};
#pragma unroll 1
        for (int step = 0; step < 18; ++step) {
            const int c = (dir == 0) ? step : (step < 2 ? 1 - step : 19 - step);
            const size_t R0 = (size_t)b * SROW + c * 128;
            LAS const float* dtpv = dtp; LAS const float* kdv = KD + 4 * fq; asm volatile("" : "+v"(dtpv), "+v"(kdv));
            bf16x8 Qf[4];
            { u32x4 r0[4], r1[4];
              const bf16_t* s0 = Pn + R0 * 3072 + 2048 + h * 128;
#pragma unroll
              for (int k = 0; k < 4; ++k) { const int q = tid + NTHREADS * k, row = q >> 4, cc = q & 15; r0[k] = *(const u32x4*)(s0 + (size_t)row * 3072 + cc * 8); r1[k] = *(const u32x4*)(s0 + 512 + (size_t)row * 3072 + cc * 8); }
              const bf16_t* qp = Pn + (R0 + iloc) * 3072 + h * 128 + 8 * fq;
#pragma unroll
              for (int ds = 0; ds < 4; ++ds) Qf[ds] = *(const bf16x8*)(qp + 32 * ds);
#pragma unroll
              for (int k = 0; k < 4; ++k) { const int q = tid + NTHREADS * k, row = q >> 4, cc = q & 15; *(LAS u32x4*)(Ks + row * RP + cc * 16) = r0[k]; *(LAS u32x4*)(Vs + row * RP + cc * 16) = r1[k]; } }
            __syncthreads();
            f32x4 accO[8];
#pragma unroll
            for (int hb = 0; hb < 4; ++hb) { bf16x8 fa[8];
#pragma unroll
                for (int q = 0; q < 8; ++q) fa[q] = ld_frag16(Ss + (16 * (2 * hb + (q >> 2)) + fr) * RP + (32 * (q & 3) + 8 * fq) * 2);
                __builtin_amdgcn_sched_barrier(0);
#pragma unroll
                for (int v2 = 0; v2 < 2; ++v2) { f32x4 a = {0.f, 0.f, 0.f, 0.f};
#pragma unroll
                    for (int ds = 0; ds < 4; ++ds) a = mfma16(fa[v2 * 4 + ds], Qf[ds], a);
                    accO[2 * hb + v2] = a * qd; }
                __builtin_amdgcn_sched_barrier(0); }
            if (dir == 1) {
#pragma unroll
            for (int jp = 0; jp < 4; ++jp) { float pv[8];
                bf16x8 fk[8];
#pragma unroll
                for (int q = 0; q < 8; ++q) fk[q] = ld_frag16(Ks + (16 * (2 * jp + (q >> 2)) + fr) * RP + (32 * (q & 3) + 8 * fq) * 2);
                __builtin_amdgcn_sched_barrier(0);
#pragma unroll
                for (int hf = 0; hf < 2; ++hf) { const int jt = 2 * jp + hf; f32x4 sc = {0.f, 0.f, 0.f, 0.f};
#pragma unroll
                    for (int ds = 0; ds < 4; ++ds) sc = mfma16(fk[hf * 4 + ds], Qf[ds], sc);
                    { const f32x4 dw = *(LAS const f32x4*)(dtpv + 16 * jt);
#pragma unroll
                      for (int r = 0; r < 4; ++r) pv[4 * hf + r] = sc[r] * dw[r]; } }
                u32x4 wv; wv.x = cvt_pk_bf16(pv[0], pv[1]); wv.y = cvt_pk_bf16(pv[2], pv[3]); wv.z = cvt_pk_bf16(pv[4], pv[5]); wv.w = cvt_pk_bf16(pv[6], pv[7]);
                const bf16x8 PBj = __builtin_bit_cast(bf16x8, wv);
                bf16x8 fv[8];
#pragma unroll
                for (int vt = 0; vt < 8; ++vt) { LAS const unsigned char* vp = Vs + (32 * jp + trq) * RP + vt * 32 + trp; fv[vt] = ld_tr8(vp, vp + 16 * RP); }
                __builtin_amdgcn_sched_barrier(0);
#pragma unroll
                for (int vt = 0; vt < 8; ++vt) accO[vt] = mfma16(fv[vt], PBj, accO[vt]);
                __builtin_amdgcn_sched_barrier(0); }
            }
            { float* ofp = OF + (R0 + iloc) * 512 + h * 128 + 4 * fq;
              if (dir == 0) {
#pragma unroll
                  for (int vt = 0; vt < 8; ++vt) *(f32x4*)(ofp + 16 * vt) = accO[vt];
              } else {
                  float s1 = 0.f;
#pragma unroll
                  for (int vt = 0; vt < 8; ++vt) { accO[vt] += *(const f32x4*)(ofp + 16 * vt); s1 += (accO[vt][0] + accO[vt][1]) + (accO[vt][2] + accO[vt][3]); }
                  s1 = xrow16_sum(s1);
                  const float mu = s1 * (1.0f / 128.0f); float s2 = 0.f;
#pragma unroll
                  for (int vt = 0; vt < 8; ++vt) { const f32x4 d = accO[vt] - mu; s2 += (d[0] * d[0] + d[1] * d[1]) + (d[2] * d[2] + d[3] * d[3]); }
                  s2 = xrow16_sum(s2);
                  const float rs = rsqrtf(s2 * (1.0f / 128.0f) + EPS);
                  const bf16_t* gp = Pn + (R0 + iloc) * 3072 + 512 + h * 128 + 4 * fq; bf16_t* op = A2 + (R0 + iloc) * 1024 + h * 128 + 4 * fq;
#pragma unroll
                  for (int vt = 0; vt < 8; ++vt) { const u32x2 g = *(const u32x2*)(gp + 16 * vt);
                      const float o0 = (accO[vt][0] - mu) * rs * silu_f(bflo(g.x)), o1 = (accO[vt][1] - mu) * rs * silu_f(bfhi(g.x));
                      const float o2 = (accO[vt][2] - mu) * rs * silu_f(bflo(g.y)), o3 = (accO[vt][3] - mu) * rs * silu_f(bfhi(g.y));
                      u32x2 wv; wv.x = cvt_pk_bf16(o0, o1); wv.y = cvt_pk_bf16(o2, o3); *(u32x2*)(op + 16 * vt) = wv; }
              } }
            bf16x8 Vd[4];
#pragma unroll
            for (int js = 0; js < 4; ++js) { LAS const unsigned char* vp = Vs + (32 * js + trq) * RP + w * 32 + trp; const u32x4 raw = __builtin_bit_cast(u32x4, ld_tr8(vp, vp + 16 * RP)); float kd[8];
                { const f32x4 k0 = *(LAS const f32x4*)(kdv + 32 * js), k1 = *(LAS const f32x4*)(kdv + 32 * js + 16); kd[0] = k0[0]; kd[1] = k0[1]; kd[2] = k0[2]; kd[3] = k0[3]; kd[4] = k1[0]; kd[5] = k1[1]; kd[6] = k1[2]; kd[7] = k1[3]; }
                u32x4 wv; wv.x = cvt_pk_bf16(bflo(raw.x) * kd[0], bfhi(raw.x) * kd[1]); wv.y = cvt_pk_bf16(bflo(raw.y) * kd[2], bfhi(raw.y) * kd[3]);
                wv.z = cvt_pk_bf16(bflo(raw.z) * kd[4], bfhi(raw.z) * kd[5]); wv.w = cvt_pk_bf16(bflo(raw.w) * kd[6], bfhi(raw.w) * kd[7]);
                Vd[js] = __builtin_bit_cast(bf16x8, wv); }
#pragma unroll
            for (int hb = 0; hb < 4; ++hb) { bf16x8 fk[8];
#pragma unroll
                for (int q = 0; q < 8; ++q) { LAS const unsigned char* kp = Ks + (32 * (q & 3) + trq) * RP + (2 * hb + (q >> 2)) * 32 + trp; fk[q] = ld_tr8(kp, kp + 16 * RP); }
                __builtin_amdgcn_sched_barrier(0);
#pragma unroll
                for (int d2 = 0; d2 < 2; ++d2) { f32x4 a = accS[2 * hb + d2] * cdec;
#pragma unroll
                    for (int js = 0; js < 4; ++js) a = mfma16(fk[d2 * 4 + js], Vd[js], a);
                    accS[2 * hb + d2] = a; }
                __builtin_amdgcn_sched_barrier(0); }
            __syncthreads();
#pragma unroll
            for (int dt = 0; dt < 8; ++dt) { u32x2 wv; wv.x = cvt_pk_bf16(accS[dt][0], accS[dt][1]); wv.y = cvt_pk_bf16(accS[dt][2], accS[dt][3]);
                *(LAS u32x2*)(Ss + (16 * w + fr) * RP + (16 * dt + 4 * fq) * 2) = wv; }
        }
    }
    __syncthreads();
}

constexpr int POOL_PIN = 0, POOL_DSM = 144 * RP, POOL_PW = POOL_DSM + 128 * RP;
template <int GI> __device__ __forceinline__ void pool_body(const Args& A, LAS unsigned char* lds, int seg, int li) {
    constexpr int win = 2 << GI, hw = win >> 1, g = GI;
    const int tid = threadIdx.x, lane = tid & 63, w = tid >> 6, fr = lane & 15, fq = lane >> 4;
    unsigned char* ws = A.ws;
    const bf16_t* Pn = (const bf16_t*)(ws + WS_P); bf16_t* A2 = (bf16_t*)(ws + WS_H);
    const size_t R0 = (size_t)seg * 128; const int s0 = (int)(R0 % SROW); const bool isctx = s0 < CTXL;
    const int TT = isctx ? CTXL : SEQ, t0 = isctx ? s0 : s0 - CTXL; const size_t Rseq = R0 - t0;
    LAS unsigned char* pin = lds + POOL_PIN; LAS unsigned char* dsm = lds + POOL_DSM; LAS const unsigned char* PWs = lds + POOL_PW;
    u32x4 rr[5];
#pragma unroll
    for (int k = 0; k < 5; ++k) { const int q = tid + NTHREADS * k, row = q >> 4, cc = q & 15, t = t0 - 8 + row; const bool ok = (q < 144 * 16) && t >= 0 && t < TT;
        rr[k] = (u32x4){0u, 0u, 0u, 0u}; if (ok) rr[k] = *(const u32x4*)(Pn + (Rseq + t) * 3072 + 1024 + g * 128 + cc * 8); }
    const size_t R = R0 + 16 * w + fr;
    const bf16_t* gp = Pn + R * 3072 + 1536 + g * 128 + 4 * fq;
    u32x2 gg[8];
#pragma unroll
    for (int dt = 0; dt < 8; ++dt) gg[dt] = *(const u32x2*)(gp + 16 * dt);
    __syncthreads();
#pragma unroll
    for (int k = 0; k < 5; ++k) { const int q = tid + NTHREADS * k; if (q < 144 * 16) *(LAS u32x4*)(pin + (q >> 4) * RP + (q & 15) * 16) = rr[k]; }
    __syncthreads();
#pragma unroll
    for (int k = 0; k < 4; ++k) { const int q = tid + NTHREADS * k, tl = q >> 4, cc = q & 15, t = t0 + tl;
        const int lo = max(t - hw, 0), hi = min(t + hw - 1, TT - 1);
        float sm[8];
#pragma unroll
        for (int e = 0; e < 8; ++e) sm[e] = 0.f;
#pragma unroll
        for (int ww = 0; ww < win; ++ww) { const u32x4 r = *(LAS const u32x4*)(pin + (tl + 8 - hw + ww) * RP + cc * 16);
            sm[0] += bflo(r.x); sm[1] += bfhi(r.x); sm[2] += bflo(r.y); sm[3] += bfhi(r.y); sm[4] += bflo(r.z); sm[5] += bfhi(r.z); sm[6] += bflo(r.w); sm[7] += bfhi(r.w); }
        const float inv = 1.0f / (float)(hi - lo + 1);
        const u32x4 c = *(LAS const u32x4*)(pin + (tl + 8) * RP + cc * 16);
        u32x4 wv; wv.x = cvt_pk_bf16(sm[0] * inv - bflo(c.x), sm[1] * inv - bfhi(c.x)); wv.y = cvt_pk_bf16(sm[2] * inv - bflo(c.y), sm[3] * inv - bfhi(c.y));
        wv.z = cvt_pk_bf16(sm[4] * inv - bflo(c.z), sm[5] * inv - bfhi(c.z)); wv.w = cvt_pk_bf16(sm[6] * inv - bflo(c.w), sm[7] * inv - bfhi(c.w));
        *(LAS u32x4*)(dsm + tl * RP + cc * 16) = wv; }
    __syncthreads();
    bf16x8 Bf[4];
#pragma unroll
    for (int cs = 0; cs < 4; ++cs) Bf[cs] = ld_frag16(dsm + (16 * w + fr) * RP + (32 * cs + 8 * fq) * 2);
    const float* psc = A.in[12] + li * 512 + g * 128 + 4 * fq;
    bf16_t* op = A2 + R * 1024 + 512 + g * 128 + 4 * fq;
#pragma unroll
    for (int hb = 0; hb < 4; ++hb) { bf16x8 fa[8];
#pragma unroll
        for (int q = 0; q < 8; ++q) fa[q] = ld_frag16(PWs + (16 * (2 * hb + (q >> 2)) + fr) * RP + (32 * (q & 3) + 8 * fq) * 2);
        __builtin_amdgcn_sched_barrier(0);
#pragma unroll
        for (int d2 = 0; d2 < 2; ++d2) { const int dt = 2 * hb + d2; f32x4 a = {0.f, 0.f, 0.f, 0.f};
#pragma unroll
            for (int cs = 0; cs < 4; ++cs) a = mfma16(fa[d2 * 4 + cs], Bf[cs], a);
            const f32x4 sc = *(const f32x4*)(psc + 16 * dt);
            u32x2 wv; wv.x = cvt_pk_bf16(a[0] * sc[0] * silu_f(bflo(gg[dt].x)), a[1] * sc[1] * silu_f(bfhi(gg[dt].x))); wv.y = cvt_pk_bf16(a[2] * sc[2] * silu_f(bflo(gg[dt].y)), a[3] * sc[3] * silu_f(bfhi(gg[dt].y)));
            *(u32x2*)(op + 16 * dt) = wv; }
        __builtin_amdgcn_sched_barrier(0); }
}
__device__ __forceinline__ void pool_stage_w(const Args& A, LAS unsigned char* lds, int g, int li) {
    const bf16_t* PW = (const bf16_t*)(A.ws + WS_PWT) + (size_t)(li * 4 + g) * 16384;
    __syncthreads();
    for (int q = threadIdx.x; q < 128 * 16; q += NTHREADS) *(LAS u32x4*)(lds + POOL_PW + (q >> 4) * RP + (q & 15) * 16) = *(const u32x4*)(PW + q * 8);
    __syncthreads();
}
__device__ __forceinline__ void pool_unit(const Args& A, LAS unsigned char* lds, int unit, int li, int& cur_g) {
    const int seg = unit >> 2, g = unit & 3;
    if (g != cur_g) { pool_stage_w(A, lds, g, li); cur_g = g; }
    switch (g) { case 0: pool_body<0>(A, lds, seg, li); break; case 1: pool_body<1>(A, lds, seg, li); break; case 2: pool_body<2>(A, lds, seg, li); break; default: pool_body<3>(A, lds, seg, li); break; }
}

#ifdef NO_RET
#define DIS_RET(...)
#else
#define DIS_RET(...) __VA_ARGS__
#endif
#ifdef NO_POOL
#define DIS_POOL(...)
#else
#define DIS_POOL(...) __VA_ARGS__
#endif
__device__ __forceinline__ void even_mixer_phase(const Args& A, LAS unsigned char* lds, int li, int part = 0) {
    const int G = gridDim.x, bx = blockIdx.x;
    const int nret = 128; int cur_g = -1;
    if (G > nret) {
        if (bx < nret) { if (part != 2) { DIS_RET(retention_unit(A, lds, bx, li);) } }
        else if (part != 1) for (int u = bx - nret; u < 576 * 4; u += G - nret) { DIS_POOL(pool_unit(A, lds, u, li, cur_g);) }
    } else {
        if (part != 2) for (int u = bx; u < nret; u += G) { DIS_RET(retention_unit(A, lds, u, li);) }
        if (part != 1) for (int u = bx; u < 576 * 4; u += G) { DIS_POOL(pool_unit(A, lds, u, li, cur_g);) }
    }
}

constexpr int KT_BYTES = 64 * 256, VT_BYTES = 64 * 256, AV_OFF = 2 * KT_BYTES;

__device__ __forceinline__ void attn_unit(const Args& A, LAS unsigned char* lds, int unit, int next_unit, bool staged, int l, float lam, float lam_init) {
    const int tid = threadIdx.x, lane = tid & 63, w = __builtin_amdgcn_readfirstlane(tid >> 6), fr = lane & 15, fq = lane >> 4;
    const int li = l >> 1;
    int b, h, qrow0, nkt;
    if (unit < 4096) { const int bh = unit >> 4, qb = unit & 15; b = bh >> 3; h = bh & 7; qrow0 = CTXL + qb * 128; nkt = 36; }
    else { const int u2 = unit - 4096, bh = u2 >> 1, qb = u2 & 1; b = bh >> 3; h = bh & 7; qrow0 = qb * 128; nkt = 4; }
    unsigned char* ws = A.ws;
    const bf16_t* Pn = (const bf16_t*)(ws + WS_P); bf16_t* A2 = (bf16_t*)(ws + WS_H);
    const size_t Rb = (size_t)b * SROW; const size_t Rq = Rb + qrow0 + 16 * w + fr;
    const float cs = 0.125f * 1.4426950408889634f;
    bf16x8 Qf[2][2];
#pragma unroll
    for (int mp = 0; mp < 2; ++mp)
#pragma unroll
        for (int ds = 0; ds < 2; ++ds) { const u32x4 raw = *(const u32x4*)(Pn + Rq * 2048 + h * 128 + mp * 64 + 32 * ds + 8 * fq); u32x4 wq;
            wq.x = cvt_pk_bf16(bflo(raw.x) * cs, bfhi(raw.x) * cs); wq.y = cvt_pk_bf16(bflo(raw.y) * cs, bfhi(raw.y) * cs); wq.z = cvt_pk_bf16(bflo(raw.z) * cs, bfhi(raw.z) * cs); wq.w = cvt_pk_bf16(bflo(raw.w) * cs, bfhi(raw.w) * cs);
            Qf[mp][ds] = __builtin_bit_cast(bf16x8, wq); }
    const bf16_t* kbase = (const bf16_t*)(ws + WS_OF) + (size_t)(b * 8 + h) * SROW * 128; const bf16_t* vbase = (const bf16_t*)(ws + WS_T) + (size_t)(b * 8 + h) * SROW * 128;
    int nb_ = 0, nh_ = 0;
    if (next_unit >= 0) { const int nbh = (next_unit < 4096) ? (next_unit >> 4) : ((next_unit - 4096) >> 1); nb_ = nbh >> 3; nh_ = nbh & 7; }
    const bf16_t* nkbase = (const bf16_t*)(ws + WS_OF) + (size_t)(nb_ * 8 + nh_) * SROW * 128; const bf16_t* nvbase = (const bf16_t*)(ws + WS_T) + (size_t)(nb_ * 8 + nh_) * SROW * 128;
    int ksrc[2], vsrc[2];
#pragma unroll
    for (int i = 0; i < 2; ++i) { const int row = (i * 8 + w) * 4 + (lane >> 4), p = lane & 15; ksrc[i] = row * 128 + (p ^ (row & 15)) * 8; vsrc[i] = row * 128 + (p ^ (2 * (row & 7))) * 8; }
#define ATT_DMA(t, kbuf, vbuf) do { const size_t to_ = (size_t)(t) * 8192; \
        _Pragma("unroll") for (int i_ = 0; i_ < 2; ++i_) { \
            __builtin_amdgcn_global_load_lds((const unsigned*)(kbase + to_ + ksrc[i_]), (LAS unsigned*)(lds + (kbuf) * KT_BYTES + (i_ * 8 + w) * 1024), 16, 0, 0); \
            __builtin_amdgcn_global_load_lds((const unsigned*)(vbase + to_ + vsrc[i_]), (LAS unsigned*)(lds + AV_OFF + (vbuf) * VT_BYTES + (i_ * 8 + w) * 1024), 16, 0, 0); } } while (0)
    int koff[2][2];
#pragma unroll
    for (int mp = 0; mp < 2; ++mp)
#pragma unroll
        for (int ds = 0; ds < 2; ++ds) koff[mp][ds] = fr * 256 + (((mp * 8 + ds * 4 + fq) ^ fr) * 16);
    const int gg32 = (4 * (fq & 1) + (fr >> 2)) * 32;
    const int vlane = (4 * fq + (fr >> 2)) * 256 + ((fr & 3) >> 1) * 16 + (fr & 1) * 8;
    f32x4 acc[2][8];
#pragma unroll
    for (int mp = 0; mp < 2; ++mp)
#pragma unroll
        for (int vt = 0; vt < 8; ++vt) acc[mp][vt] = (f32x4){0.f, 0.f, 0.f, 0.f};
    float lsum[2] = {0.f, 0.f}; f32x4 negm[2] = {{0.f, 0.f, 0.f, 0.f}, {0.f, 0.f, 0.f, 0.f}};
#define ATT_TILE(KOFF, VOFF, first) do { LAS const unsigned char* kb = lds + (KOFF); LAS const unsigned char* vb_ = lds + (VOFF) + vlane; \
        f32x4 s[2][4]; \
        _Pragma("unroll") for (int mp = 0; mp < 2; ++mp) { bf16x8 kf[8]; \
            _Pragma("unroll") for (int q = 0; q < 8; ++q) kf[q] = ld_frag16(kb + (q >> 1) * 4096 + koff[mp][q & 1]); \
            __builtin_amdgcn_sched_barrier(0); \
            _Pragma("unroll") for (int jt = 0; jt < 4; ++jt) s[mp][jt] = mfma16(kf[jt * 2 + 1], Qf[mp][1], mfma16(kf[jt * 2], Qf[mp][0], negm[mp])); \
            __builtin_amdgcn_sched_barrier(0); } \
        bf16x8 PB[2][2]; float ps[2]; \
        _Pragma("unroll") for (int mp = 0; mp < 2; ++mp) { float a_ = 0.f; f32x4 p[4]; \
            _Pragma("unroll") for (int jt = 0; jt < 4; ++jt) _Pragma("unroll") for (int r = 0; r < 4; ++r) { p[jt][r] = __builtin_amdgcn_exp2f(s[mp][jt][r]); a_ += p[jt][r]; } \
            ps[mp] = a_; \
            _Pragma("unroll") for (int jp = 0; jp < 2; ++jp) { u32x4 wv; wv.x = cvt_pk_bf16(p[2 * jp][0], p[2 * jp][1]); wv.y = cvt_pk_bf16(p[2 * jp][2], p[2 * jp][3]); \
                wv.z = cvt_pk_bf16(p[2 * jp + 1][0], p[2 * jp + 1][1]); wv.w = cvt_pk_bf16(p[2 * jp + 1][2], p[2 * jp + 1][3]); PB[mp][jp] = __builtin_bit_cast(bf16x8, wv); } } \
        if ((first) || __any(!(fmaxf(ps[0], ps[1]) < 512.0f))) { \
            _Pragma("unroll") for (int mp = 0; mp < 2; ++mp) { \
                float m_ = fmaxf(fmaxf(s[mp][0][0], s[mp][0][1]), fmaxf(s[mp][0][2], s[mp][0][3])); \
                _Pragma("unroll") for (int jt = 1; jt < 4; ++jt) m_ = fmaxf(fmaxf(m_, s[mp][jt][0]), fmaxf(fmaxf(s[mp][jt][1], s[mp][jt][2]), s[mp][jt][3])); \
                m_ = xrow16_max(m_); \
                const float delta = (first) ? m_ : fmaxf(m_, 0.f); \
                const float alpha = (first) ? 0.f : __builtin_amdgcn_exp2f(-delta); \
                negm[mp] -= delta; lsum[mp] *= alpha; \
                _Pragma("unroll") for (int vt = 0; vt < 8; ++vt) acc[mp][vt] *= alpha; \
                float a_ = 0.f; f32x4 p[4]; \
                _Pragma("unroll") for (int jt = 0; jt < 4; ++jt) _Pragma("unroll") for (int r = 0; r < 4; ++r) { p[jt][r] = __builtin_amdgcn_exp2f(s[mp][jt][r] - delta); a_ += p[jt][r]; } \
                ps[mp] = a_; \
                _Pragma("unroll") for (int jp = 0; jp < 2; ++jp) { u32x4 wv; wv.x = cvt_pk_bf16(p[2 * jp][0], p[2 * jp][1]); wv.y = cvt_pk_bf16(p[2 * jp][2], p[2 * jp][3]); \
                    wv.z = cvt_pk_bf16(p[2 * jp + 1][0], p[2 * jp + 1][1]); wv.w = cvt_pk_bf16(p[2 * jp + 1][2], p[2 * jp + 1][3]); PB[mp][jp] = __builtin_bit_cast(bf16x8, wv); } } \
        } \
        lsum[0] += ps[0]; lsum[1] += ps[1]; \
        _Pragma("unroll") for (int hb_ = 0; hb_ < 2; ++hb_) { bf16x8 vf_[8]; \
            _Pragma("unroll") for (int q_ = 0; q_ < 8; ++q_) { LAS const unsigned char* vp = vb_ + (q_ & 1) * (32 * 256) + (((hb_ * 4 + (q_ >> 1)) * 32) ^ gg32); vf_[q_] = ld_tr8(vp, vp + 16 * 256); } \
            __builtin_amdgcn_sched_barrier(0); \
            _Pragma("unroll") for (int q_ = 0; q_ < 8; ++q_) { acc[0][hb_ * 4 + (q_ >> 1)] = mfma16(vf_[q_], PB[0][q_ & 1], acc[0][hb_ * 4 + (q_ >> 1)]); acc[1][hb_ * 4 + (q_ >> 1)] = mfma16(vf_[q_], PB[1][q_ & 1], acc[1][hb_ * 4 + (q_ >> 1)]); } \
            __builtin_amdgcn_sched_barrier(0); } } while (0)
#define ATT_DMA2(t, KOFF, VOFF) do { const size_t to_ = (size_t)(t) * 8192; \
        _Pragma("unroll") for (int i_ = 0; i_ < 2; ++i_) { \
            __builtin_amdgcn_global_load_lds((const unsigned*)(kbase + to_ + ksrc[i_]), (LAS unsigned*)(lds + (KOFF) + (i_ * 8 + w) * 1024), 16, 0, 0); \
            __builtin_amdgcn_global_load_lds((const unsigned*)(vbase + to_ + vsrc[i_]), (LAS unsigned*)(lds + (VOFF) + (i_ * 8 + w) * 1024), 16, 0, 0); } } while (0)
    if (!staged) {
        __syncthreads();
        ATT_DMA2(0, 0, 16384);
        asm volatile("s_waitcnt vmcnt(0)" ::: "memory");
        __syncthreads();
    }
    const int nit = nkt >> 1;
    for (int it = 0; it < nit; ++it) {
        ATT_DMA2(2 * it + 1, 32768, 49152);
        ATT_TILE(0, 16384, it == 0);
        asm volatile("s_waitcnt vmcnt(0)" ::: "memory");
        __syncthreads();
        if (it + 1 < nit) ATT_DMA2(2 * it + 2, 0, 16384);
        else if (next_unit >= 0) {
#pragma unroll
            for (int i_ = 0; i_ < 2; ++i_) {
                __builtin_amdgcn_global_load_lds((const unsigned*)(nkbase + ksrc[i_]), (LAS unsigned*)(lds + 0 + (i_ * 8 + w) * 1024), 16, 0, 0);
                __builtin_amdgcn_global_load_lds((const unsigned*)(nvbase + vsrc[i_]), (LAS unsigned*)(lds + 16384 + (i_ * 8 + w) * 1024), 16, 0, 0); } }
        ATT_TILE(32768, 49152, false);
        asm volatile("s_waitcnt vmcnt(0)" ::: "memory");
        __syncthreads();
    }
#undef ATT_TILE
#undef ATT_DMA2
#undef ATT_DMA
#undef ATT_PV
    float l0 = lsum[0], l1 = lsum[1];
    l0 = xrow16_sum(l0); l1 = xrow16_sum(l1);
    const float i0 = 1.0f / l0, i1 = lam / l1;
    float ss = 0.f;
#pragma unroll
    for (int vt = 0; vt < 8; ++vt) { acc[0][vt] = acc[0][vt] * i0 - acc[1][vt] * i1; ss += (acc[0][vt][0] * acc[0][vt][0] + acc[0][vt][1] * acc[0][vt][1]) + (acc[0][vt][2] * acc[0][vt][2] + acc[0][vt][3] * acc[0][vt][3]); }
    ss = xrow16_sum(ss);
    const float rs = rsqrtf(ss * (1.0f / 128.0f) + EPS) * (1.0f - lam_init);
    const float* sub = A.in[16] + li * 128 + 4 * fq; const bf16_t* gp = Pn + Rq * 2048 + 1024 + h * 128 + 4 * fq; bf16_t* op = A2 + Rq * 1024 + h * 128 + 4 * fq;
#pragma unroll
    for (int vt = 0; vt < 8; ++vt) { const f32x4 sb = *(const f32x4*)(sub + 16 * vt); const u32x2 g = *(const u32x2*)(gp + 16 * vt);
        u32x2 wv; wv.x = cvt_pk_bf16(acc[0][vt][0] * rs * sb[0] * silu_f(bflo(g.x)), acc[0][vt][1] * rs * sb[1] * silu_f(bfhi(g.x)));
        wv.y = cvt_pk_bf16(acc[0][vt][2] * rs * sb[2] * silu_f(bflo(g.y)), acc[0][vt][3] * rs * sb[3] * silu_f(bfhi(g.y)));
        *(u32x2*)(op + 16 * vt) = wv; }
}

__device__ __forceinline__ void odd_mixer_phase(const Args& A, LAS unsigned char* lds, int l) {
    const int G = gridDim.x, bx = blockIdx.x, li = l >> 1;
    const float* lp = A.in[15] + li * 256; float d0 = 0.f, d1 = 0.f;
    for (int e = 0; e < 64; ++e) { d0 += lp[e] * lp[64 + e]; d1 += lp[128 + e] * lp[192 + e]; }
    const float lam_init = 0.8f - 0.6f * expf(-0.3f * (float)l);
    const float lam = expf(d0) - expf(d1) + lam_init;
    const int vcu = (G % 8 == 0) ? (bx % 8) * (G / 8) + bx / 8 : bx;
    const int nunits = (l == 3) ? 4096 : 4608;
    bool staged = false;
    for (int u = vcu; u < nunits; u += G) { const int nu = (u + G < nunits) ? u + G : -1; attn_unit(A, lds, u, nu, staged, l, lam, lam_init); staged = nu >= 0; }
}


#define XB_TMO      128
#define XB_XCNT(j)  (256  + 64 * (j))
#define XB_XSUB(j)  (1280 + 64 * (j))
#define XB_XGEN(j)  (2304 + 64 * (j))
#define XB_TOP      3328
#define XB_TOPGEN   3392
#define XCD_BAR_WORDS 3456
#define XB_SPIN_CAP (1u << 18)

__device__ __forceinline__ unsigned xb_ld(unsigned* p)              { return __hip_atomic_load(p, __ATOMIC_RELAXED, __HIP_MEMORY_SCOPE_AGENT); }
__device__ __forceinline__ unsigned xb_add(unsigned* p, unsigned v) { return __hip_atomic_fetch_add(p, v, __ATOMIC_RELAXED, __HIP_MEMORY_SCOPE_AGENT); }
__device__ __forceinline__ unsigned xb_xcc_id() { return (unsigned)__builtin_amdgcn_s_getreg((3 << 11) | 20) & 0xFu; }
#define XB_SPIN(cond, bar) do { unsigned _sp = 0; while (cond) { __builtin_amdgcn_s_sleep(1); \
    if ((++_sp & 255u) == 0u) { if (xb_ld(&(bar)[XB_TMO])) break; if (_sp > XB_SPIN_CAP) { atomicAdd(&(bar)[XB_TMO], 1u); break; } } } } while (0)

struct XcdBarrier {
    unsigned* bar; unsigned x;
    volatile LAS unsigned* st;
};

__device__ __forceinline__ XcdBarrier xcd_barrier_post(unsigned* bar, volatile LAS unsigned* st) {
    XcdBarrier b; b.bar = bar; b.x = xb_xcc_id(); b.st = st;
    if (threadIdx.x == 0) (void)xb_add(&bar[XB_XCNT(b.x)], 1u);
    return b;
}
__device__ __forceinline__ void xcd_barrier_complete(unsigned* bar, unsigned x, unsigned& nloc, unsigned& nx) {
    const unsigned G = gridDim.x * gridDim.y * gridDim.z;
    unsigned sum, cnt, mine, sp = 0u;
    for (;;) {
        sum = 0u; cnt = 0u; mine = 0u;
#pragma unroll
        for (unsigned j = 0; j < 16; ++j) { const unsigned c = xb_ld(&bar[XB_XCNT(j)]); sum += c; cnt += (c > 0u) ? 1u : 0u; mine = (j == x) ? c : mine; }
        if (sum == G) break;
        __builtin_amdgcn_s_sleep(1);
        if ((++sp & 255u) == 0u) { if (xb_ld(&bar[XB_TMO])) break; if (sp > XB_SPIN_CAP) { atomicAdd(&bar[XB_TMO], 1u); break; } }
    }
    nloc = mine > 0u ? mine : 1u; nx = cnt > 0u ? cnt : 1u;
}

__device__ __forceinline__ void xcd_barrier(const XcdBarrier& b) {
    asm volatile("s_waitcnt vmcnt(0)" ::: "memory");
    __syncthreads();
    if (threadIdx.x == 0) {
        unsigned* bar = b.bar;
        __builtin_amdgcn_s_waitcnt(0);
        unsigned nloc = b.st[0], nx = b.st[1];
        if (nloc == 0u) { xcd_barrier_complete(bar, b.x, nloc, nx); b.st[0] = nloc; b.st[1] = nx; }
        const unsigned old = xb_add(&bar[XB_XSUB(b.x)], 1u);
        const unsigned gen = old / nloc;
        if (old + 1u == (gen + 1u) * nloc) {
            __builtin_amdgcn_fence(__ATOMIC_RELEASE, "agent");
            asm volatile("s_waitcnt vmcnt(0)" ::: "memory");
            const unsigned og = xb_add(&bar[XB_TOP], 1u);
            const unsigned tg = og / nx;
            if (og + 1u == (tg + 1u) * nx) xb_add(&bar[XB_TOPGEN], 1u);
            else XB_SPIN(xb_ld(&bar[XB_TOPGEN]) == tg, bar);
            __builtin_amdgcn_fence(__ATOMIC_ACQUIRE, "agent");
            xb_add(&bar[XB_XGEN(b.x)], 1u);
            asm volatile("s_waitcnt vmcnt(0)" ::: "memory");
        } else {
            XB_SPIN(xb_ld(&bar[XB_XGEN(b.x)]) == gen, bar);
            __builtin_amdgcn_fence(__ATOMIC_ACQUIRE, "agent");
            asm volatile("s_waitcnt vmcnt(0)" ::: "memory");
        }
    }
    __syncthreads();
}


#ifdef NO_PRO
#define DIS_PRO(...)
#else
#define DIS_PRO(...) __VA_ARGS__
#endif
#ifdef NO_EW
#define DIS_EW(...)
#else
#define DIS_EW(...) __VA_ARGS__
#endif
#ifdef NO_EVEN
#define DIS_EVEN(...)
#else
#define DIS_EVEN(...) __VA_ARGS__
#endif
#ifdef NO_ODD
#define DIS_ODD(...)
#else
#define DIS_ODD(...) __VA_ARGS__
#endif
#ifdef NO_G1
#define DIS_G1(...)
#else
#define DIS_G1(...) __VA_ARGS__
#endif
#ifdef NO_G2
#define DIS_G2(...)
#else
#define DIS_G2(...) __VA_ARGS__
#endif
#ifdef NO_G3
#define DIS_G3(...)
#else
#define DIS_G3(...) __VA_ARGS__
#endif
template <bool EXTRA> struct TrimOrder : pg8::StaticOrder {
    __device__ void init2(int ncoltiles, int G_, int c_) { init(256 * 256, ncoltiles * 256, G_, c_); }
    __device__ bool next(int i, pg8::Unit& u) const {
        const long L = (long)i * G + c;
        if (L < nwg) { pg8::StaticOrder::next(i, u); u.pm = (u.pm >> 3) * 9 + (u.pm & 7) + 1; return true; }
        if (EXTRA) { const int L2 = (int)(L - nwg); if (L2 >= 256) return false; u.pm = 9 * (L2 >> 3); const int t = L2 & 7; u.pn = t < 4 ? 4 + t : 8 + t; return true; }
        return false;
    }
};
template <int PH> __device__ __forceinline__ void run_phase(const Args& A, LAS unsigned char* lds) {
    unsigned char* ws = A.ws;
    const int G = gridDim.x, bx = blockIdx.x;
    if constexpr (PH == 0) { DIS_PRO(prologue_phase(A, lds);) }
    else if constexpr (PH == 1) { DIS_EW(ew_phase(A, 0);) }
    else {
        constexpr int l = (PH - 2) >> 2, sub = (PH - 2) & 3, li = l >> 1;
        const bf16_t* H = (const bf16_t*)(ws + WS_H);
        if constexpr (sub == 0) {
            if constexpr ((l & 1) == 0) {
                const bf16_t* W = (const bf16_t*)(ws + WS_WTE) + (size_t)li * 3072 * 1024;
                pg8::Gemm g{H, W, NTOK, 3072, 1024}; pg8::StaticOrder S; S.init(NTOK, 3072, G, bx);
                EpiInNat<0> E{(bf16_t*)(ws + WS_P), 3072, (const f32x4*)(ws + WS_TABR), nullptr, nullptr};
                DIS_G1(pg8::gemm_phase<EpiInNat<0>, pg8::StaticOrder>(lds, g, S, E, nullptr);)
            } else {
                const bf16_t* W = (const bf16_t*)(ws + WS_WTO) + (size_t)li * 4096 * 1024;
                pg8::Gemm g{H, W, NTOK, 4096, 1024};
                EpiInNat<1> E{(bf16_t*)(ws + WS_P), 2048, (const f32x4*)(ws + WS_TABD), (bf16_t*)(ws + WS_OF), (bf16_t*)(ws + WS_T)};
                if constexpr (l == 3) { TrimOrder<true> S; S.init2(16, G, bx); DIS_G1(pg8::gemm_phase<EpiInNat<1>, TrimOrder<true>>(lds, g, S, E, nullptr);) }
                else { pg8::StaticOrder S; S.init(NTOK, 4096, G, bx); DIS_G1(pg8::gemm_phase<EpiInNat<1>, pg8::StaticOrder>(lds, g, S, E, nullptr);) }
            }
        } else if constexpr (sub == 1) {
            if constexpr ((l & 1) == 0) { DIS_EVEN(even_mixer_phase(A, lds, li);) } else { DIS_ODD(odd_mixer_phase(A, lds, l);) }
        } else if constexpr (sub == 2) {
            pg8::Gemm g{H, (const bf16_t*)(ws + WS_WOT) + (size_t)l * 1024 * 1024, NTOK, 1024, 1024};
            EpiY16 E{(bf16_t*)(ws + WS_P), 1024};
            if constexpr (l == 3) { TrimOrder<false> S; S.init2(4, G, bx); DIS_G3(pg8::gemm_phase<EpiY16, TrimOrder<false>>(lds, g, S, E, nullptr);) }
            else { pg8::StaticOrder S; S.init(NTOK, 1024, G, bx); DIS_G3(pg8::gemm_phase<EpiY16, pg8::StaticOrder>(lds, g, S, E, nullptr);) }
        } else { DIS_EW(ew_phase(A, l + 1);) }
    }
}
__global__ void __launch_bounds__(NTHREADS, 2) mk_fwd(Args A) {
    extern __shared__ __attribute__((aligned(16))) unsigned char lds_raw[];
    LAS unsigned char* lds = (LAS unsigned char*)lds_raw;
    cg::grid_group grid = cg::this_grid();
    volatile LAS unsigned* bst = (volatile LAS unsigned*)(lds + LDS_BYTES - 64);
    if (threadIdx.x < 2) bst[threadIdx.x] = 0u;
    __syncthreads();
    XcdBarrier xbar = xcd_barrier_post((unsigned*)(A.ws + WS_BAR), bst);
    int nsync = 0;
#ifndef REP_KIND
#define REP_KIND -1
#endif
#define KIND_OF(ph) ((ph) == 0 ? 4 : (ph) == 1 ? 9 : (((ph) - 2) & 3) == 0 ? 0 : (((ph) - 2) & 3) == 2 ? 3 : (((ph) - 2) & 3) == 3 ? 9 : (((((ph) - 2) >> 2) & 1) == 0 ? 1 : 2))
#define RUN(ph) if (A.ph_lo <= (ph) && (ph) < A.ph_hi) { run_phase<ph>(A, lds); if (KIND_OF(ph) == REP_KIND) { __syncthreads(); run_phase<ph>(A, lds); } if (KIND_OF(ph) == 1 && (REP_KIND == 5 || REP_KIND == 6)) { __syncthreads(); even_mixer_phase(A, lds, (((ph) - 2) >> 2) >> 1, REP_KIND - 4); } if ((ph) + 1 < A.ph_hi) { if (A.ph_hi > 1000) grid.sync(); else xcd_barrier(xbar); ++nsync;        if (REP_KIND == 7) { xcd_barrier(xbar); xcd_barrier(xbar); xcd_barrier(xbar); xcd_barrier(xbar); } } }
    RUN(0) RUN(1) RUN(2) RUN(3) RUN(4) RUN(5) RUN(6) RUN(7) RUN(8) RUN(9) RUN(10) RUN(11) RUN(12) RUN(13) RUN(14) RUN(15) RUN(16) RUN(17)
#undef RUN
}

#ifndef MK_MULTI
#define MK_MULTI 0
#endif
constexpr int NPHASES = 18;
extern "C" void kernel_launch(void* const* d_in, const int* in_sizes, int n_in, void* d_out, int out_size, void* d_ws, size_t ws_size, hipStream_t stream) {
    static int grid = 0;
    if (grid == 0) {
        if (n_in != 17 || ws_size < WS_END) { fprintf(stderr, "kernel_launch: unexpected inputs (n_in %d, ws %zu)\n", n_in, ws_size); grid = -1; return; }
        int dev = 0, cus = 0, per_cu = 0;
        hipGetDevice(&dev); hipDeviceGetAttribute(&cus, hipDeviceAttributeMultiprocessorCount, dev);
        if (hipFuncSetAttribute((const void*)mk_fwd, hipFuncAttributeMaxDynamicSharedMemorySize, LDS_BYTES) != hipSuccess) { fprintf(stderr, "kernel_launch: hipFuncSetAttribute failed\n"); grid = -1; return; }
        if (hipOccupancyMaxActiveBlocksPerMultiprocessor(&per_cu, (const void*)mk_fwd, NTHREADS, LDS_BYTES) != hipSuccess || per_cu < 1) { fprintf(stderr, "kernel_launch: occupancy query gave %d\n", per_cu); per_cu = 1; }
        (void)hipGetLastError();
        grid = cus * per_cu;
    }
    if (grid < 0) return;
    if (hipMemsetAsync((char*)d_ws + WS_BAR, 0, 16384, stream) != hipSuccess) { fprintf(stderr, "kernel_launch: memset failed\n"); return; }
    Args a{};
    for (int i = 0; i < 17; ++i) a.in[i] = (const float*)d_in[i];
    a.out = (float*)d_out; a.ws = (unsigned char*)d_ws;
#if MK_MULTI
    for (int ph = 0; ph < NPHASES; ++ph) { a.ph_lo = ph; a.ph_hi = ph + 1; hipLaunchKernelGGL(mk_fwd, dim3(grid), dim3(NTHREADS), LDS_BYTES, stream, a); }
#else
    a.ph_lo = 0; a.ph_hi = NPHASES;
    void* args[] = {&a};
    hipError_t e = hipLaunchCooperativeKernel((const void*)mk_fwd, dim3(grid), dim3(NTHREADS), args, LDS_BYTES, stream);
    if (e != hipSuccess) fprintf(stderr, "kernel_launch: cooperative launch failed: %s (grid %d)\n", hipGetErrorString(e), grid);
#endif
}
```
